# Optimizing an MI355X kernel written in HIP

```python
import math
import jax, jax.numpy as jnp
from jax import lax
import numpy as np

D_MODEL = 2048
BATCH = 2
SEQ = 4096
DEPTH = 2

HEAD_DIM = 128
N_HEADS_TOTAL = D_MODEL // HEAD_DIM
N_HEADS_SB = N_HEADS_TOTAL // 4
N_HEADS_DIFF = N_HEADS_TOTAL // 4
N_HEADS_DIL = N_HEADS_TOTAL - N_HEADS_SB - N_HEADS_DIFF
DIFF_QK_DIM = HEAD_DIM // 2
W_SB = N_HEADS_SB * HEAD_DIM
W_DIFF = N_HEADS_DIFF * HEAD_DIM
W_DIL = N_HEADS_DIL * HEAD_DIM
MIX_WIDTH = W_SB + W_DIFF + W_DIL
IN_PROJ_WIDTH = 3 * MIX_WIDTH
D_FF = ((8 * D_MODEL // 3 + 255) // 256) * 256
ROPE_THETA = 500000.0
ROPE_FRACTION = 0.25
DILATED_PATTERNS = ((128, 1), (512, 4), (2048, 16))
BLOCK_Q = 128
NORM_EPS = 1e-6

kernel_name = "hybrid_sb_diff_dilated_parallel_heads"


def rmsnorm(x, g):
    x32 = x.astype(jnp.float32)
    y = x32 * lax.rsqrt(jnp.mean(x32 * x32, axis=-1, keepdims=True) + NORM_EPS)
    return y.astype(x.dtype) * g


def partial_rope(x, positions):
    rot = int(x.shape[-1] * ROPE_FRACTION)
    half = rot // 2
    inv_freq = ROPE_THETA ** (-jnp.arange(half, dtype=jnp.float32) / half)
    ang = positions.astype(jnp.float32)[:, None, :, None] * inv_freq
    cos, sin = jnp.cos(ang), jnp.sin(ang)
    xr = x[..., :rot].astype(jnp.float32)
    x1, x2 = xr[..., :half], xr[..., half:]
    rotated = jnp.concatenate([x1 * cos - x2 * sin, x2 * cos + x1 * sin], axis=-1)
    return jnp.concatenate([rotated.astype(x.dtype), x[..., rot:]], axis=-1)


def to_heads(t, n_heads, dh):
    b, s, _ = t.shape
    return t.reshape(b, s, n_heads, dh).transpose(0, 2, 1, 3)


def merge_heads(t):
    b, h, s, dh = t.shape
    return t.transpose(0, 2, 1, 3).reshape(b, s, h * dh)


def query_blocks(q):
    *lead, s, dh = q.shape
    nb = s // BLOCK_Q
    qb = q.reshape(*lead, nb, BLOCK_Q, dh)
    return jnp.moveaxis(qb, -3, 0), nb


def unblock(o):
    o = jnp.moveaxis(o, 0, -3)
    *lead, nb, bq, dh = o.shape
    return o.reshape(*lead, nb * bq, dh)


def stick_breaking_attention(q, k, v):
    s_len, dh = q.shape[-2], q.shape[-1]
    scale = dh ** -0.5
    qb, nb = query_blocks(q)
    key_pos = jnp.arange(s_len)

    def one_block(args):
        blk, qblk = args
        q_pos = blk * BLOCK_Q + jnp.arange(BLOCK_Q)
        z = jnp.einsum('bhqd,bhkd->bhqk', qblk, k, preferred_element_type=jnp.float32) * scale
        strict = key_pos[None, :] < q_pos[:, None]
        neg_log_keep = jnp.where(strict, jax.nn.softplus(z), 0.0)
        between = lax.cumsum(neg_log_keep, axis=3, reverse=True) - neg_log_keep
        a = jnp.where(strict, jnp.exp(jax.nn.log_sigmoid(z) - between), 0.0)
        return jnp.einsum('bhqk,bhkd->bhqd', a.astype(v.dtype), v)

    return unblock(lax.map(one_block, (jnp.arange(nb), qb)))


def differential_attention(q2, k2, v, lam):
    s_len, dqk = q2.shape[-2], q2.shape[-1]
    scale = dqk ** -0.5
    qb, nb = query_blocks(q2)
    key_pos = jnp.arange(s_len)

    def one_block(args):
        blk, qblk = args
        q_pos = blk * BLOCK_Q + jnp.arange(BLOCK_Q)
        sc = jnp.einsum('cbhqd,cbhkd->cbhqk', qblk, k2, preferred_element_type=jnp.float32) * scale
        causal = key_pos[None, :] <= q_pos[:, None]
        p = jax.nn.softmax(jnp.where(causal, sc, -jnp.inf), axis=-1)
        attn = p[0] - lam * p[1]
        return jnp.einsum('bhqk,bhkd->bhqd', attn.astype(v.dtype), v)

    return unblock(lax.map(one_block, (jnp.arange(nb), qb)))


def dilated_attention(q, k, v):
    dh = q.shape[-1]
    scale = dh ** -0.5
    qb, nb = query_blocks(q)

    def one_block(args):
        blk, qblk = args
        q_pos = blk * BLOCK_Q + jnp.arange(BLOCK_Q)
        outs, lses = [], []
        for window, dilation in DILATED_PATTERNS:
            n_keys = window // dilation + 1
            idx = q_pos[:, None] - dilation * jnp.arange(n_keys)[None, :]
            valid = idx >= 0
            idx_c = jnp.maximum(idx, 0)
            kg = jnp.take(k, idx_c, axis=2)
            vg = jnp.take(v, idx_c, axis=2)
            sc = jnp.einsum('bhqd,bhqmd->bhqm', qblk, kg, preferred_element_type=jnp.float32) * scale
            sc = jnp.where(valid, sc, -jnp.inf)
            m = jnp.max(sc, axis=-1, keepdims=True)
            p = jnp.exp(sc - m)
            l = jnp.sum(p, axis=-1, keepdims=True)
            outs.append(jnp.einsum('bhqm,bhqmd->bhqd', (p / l).astype(v.dtype), vg))
            lses.append(m + jnp.log(l))
        w = jax.nn.softmax(jnp.concatenate(lses, axis=-1), axis=-1)
        o = jnp.einsum('pbhqd,bhqp->bhqd', jnp.stack(outs).astype(jnp.float32), w)
        return o.astype(v.dtype)

    return unblock(lax.map(one_block, (jnp.arange(nb), qb)))


def mixing_sublayer(h, positions, layer_idx, w_in, lambda_q1, lambda_k1, lambda_q2, lambda_k2,
                    g_sb_out, g_diff_out, g_dil_out, w_out):
    b, s, _ = h.shape
    proj = h @ w_in
    o0 = 0
    sb_q, sb_k, sb_v = (proj[..., o0 + i * W_SB:o0 + (i + 1) * W_SB] for i in range(3))
    o0 += 3 * W_SB
    df_q, df_k, df_v = (proj[..., o0 + i * W_DIFF:o0 + (i + 1) * W_DIFF] for i in range(3))
    o0 += 3 * W_DIFF
    dl_q, dl_k, dl_v = (proj[..., o0 + i * W_DIL:o0 + (i + 1) * W_DIL] for i in range(3))

    o_sb = stick_breaking_attention(to_heads(sb_q, N_HEADS_SB, HEAD_DIM),
                                    to_heads(sb_k, N_HEADS_SB, HEAD_DIM),
                                    to_heads(sb_v, N_HEADS_SB, HEAD_DIM))
    o_sb = rmsnorm(o_sb, g_sb_out)

    def two_component(t):
        return t.reshape(b, s, N_HEADS_DIFF, 2, DIFF_QK_DIM).transpose(3, 0, 2, 1, 4)
    dq = partial_rope(two_component(df_q), positions)
    dk = partial_rope(two_component(df_k), positions)
    lambda_init = 0.8 - 0.6 * math.exp(-0.3 * layer_idx)
    lam = (jnp.exp(jnp.sum(lambda_q1.astype(jnp.float32) * lambda_k1.astype(jnp.float32)))
           - jnp.exp(jnp.sum(lambda_q2.astype(jnp.float32) * lambda_k2.astype(jnp.float32)))
           + lambda_init)
    o_df = differential_attention(dq, dk, to_heads(df_v, N_HEADS_DIFF, HEAD_DIM), lam)
    o_df = rmsnorm(o_df, g_diff_out) * (1.0 - lambda_init)

    cq = partial_rope(to_heads(dl_q, N_HEADS_DIL, HEAD_DIM), positions)
    ck = partial_rope(to_heads(dl_k, N_HEADS_DIL, HEAD_DIM), positions)
    o_dl = dilated_attention(cq, ck, to_heads(dl_v, N_HEADS_DIL, HEAD_DIM))
    o_dl = rmsnorm(o_dl, g_dil_out)

    mixed = jnp.concatenate([merge_heads(o_sb), merge_heads(o_df), merge_heads(o_dl)], axis=-1)
    return mixed @ w_out


def swiglu_ffn(h, w_gate, w_up, w_down):
    return (jax.nn.silu(h @ w_gate) * (h @ w_up)) @ w_down


def setup_inputs(seed: int = 0) -> dict:
    key = jax.random.key(seed)
    ks = jax.random.split(key, 16)
    f32 = jnp.float32

    def nrm(k, shape, scale):
        return jax.random.normal(k, shape, f32) * scale

    def gain(k, shape):
        return 1.0 + 0.02 * jax.random.normal(k, shape, f32)

    x = jax.random.normal(ks[0], (BATCH, SEQ, D_MODEL), f32)
    positions = jnp.broadcast_to(jnp.arange(SEQ, dtype=jnp.int32)[None, :], (BATCH, SEQ))
    return {
        "x": x,
        "positions": positions,
        "norm_mix_g": gain(ks[1], (DEPTH, D_MODEL)),
        "w_in": nrm(ks[2], (DEPTH, D_MODEL, IN_PROJ_WIDTH), D_MODEL ** -0.5),
        "lambda_q1": nrm(ks[3], (DEPTH, DIFF_QK_DIM), 0.1),
        "lambda_k1": nrm(ks[4], (DEPTH, DIFF_QK_DIM), 0.1),
        "lambda_q2": nrm(ks[5], (DEPTH, DIFF_QK_DIM), 0.1),
        "lambda_k2": nrm(ks[6], (DEPTH, DIFF_QK_DIM), 0.1),
        "g_sb_out": gain(ks[7], (DEPTH, HEAD_DIM)),
        "g_diff_out": gain(ks[8], (DEPTH, HEAD_DIM)),
        "g_dil_out": gain(ks[9], (DEPTH, HEAD_DIM)),
        "w_out": nrm(ks[10], (DEPTH, MIX_WIDTH, D_MODEL), MIX_WIDTH ** -0.5),
        "norm_ffn_g": gain(ks[11], (DEPTH, D_MODEL)),
        "w_gate": nrm(ks[12], (DEPTH, D_MODEL, D_FF), D_MODEL ** -0.5),
        "w_up": nrm(ks[13], (DEPTH, D_MODEL, D_FF), D_MODEL ** -0.5),
        "w_down": nrm(ks[14], (DEPTH, D_FF, D_MODEL), D_FF ** -0.5),
        "norm_final_g": gain(ks[15], (D_MODEL,)),
    }


def reference(x, positions, norm_mix_g, w_in, lambda_q1, lambda_k1, lambda_q2, lambda_k2,
              g_sb_out, g_diff_out, g_dil_out, w_out, norm_ffn_g, w_gate, w_up, w_down,
              norm_final_g):
    for layer in range(DEPTH):
        h = rmsnorm(x, norm_mix_g[layer])
        x = x + mixing_sublayer(h, positions, layer, w_in[layer],
                                lambda_q1[layer], lambda_k1[layer], lambda_q2[layer], lambda_k2[layer],
                                g_sb_out[layer], g_diff_out[layer], g_dil_out[layer], w_out[layer])
        h = rmsnorm(x, norm_ffn_g[layer])
        x = x + swiglu_ffn(h, w_gate[layer], w_up[layer], w_down[layer])
    return rmsnorm(x, norm_final_g)
```

```cpp
#include <hip/hip_runtime.h>
#include <hip/hip_cooperative_groups.h>
#include <cstdio>
#include <cstdint>
#include <cmath>
namespace cg = cooperative_groups;
namespace pg8 {
#define PG8_LAS __attribute__((address_space(3)))
typedef unsigned short bf16_t;
typedef short bf16x8 __attribute__((ext_vector_type(8)));
typedef float f32x4 __attribute__((ext_vector_type(4)));
typedef unsigned u32x4 __attribute__((ext_vector_type(4)));
constexpr int BM = 256, BK = 64, HALF = 128, HTB = HALF * BK * 2  , STAGE_BYTES = 8 * HTB, NXCD = 8, WGM = 8;

__host__ __device__ __forceinline__ int lds_byte(int r, int c) { const int st = (r >> 4) * 2 + (c >> 5), rr = r & 15, cc = c & 31, ob = rr * 64 + cc * 2; return st * 1024 + (ob ^ (((ob >> 9) & 1) << 5)); }
__host__ __device__ __forceinline__ void stage_rc(int b, int& R, int& C) { const int st = b / 1024, sb = b % 1024, swz = sb ^ (((sb >> 9) & 1) << 5); R = (st >> 1) * 16 + swz / 64; C = (st & 1) * 32 + (swz % 64) / 2; }
__host__ __device__ __forceinline__ int perm32(int rho) { const int n = rho >> 4, i = rho & 15; return 8 * (i >> 2) + 4 * n + (i & 3); }

struct Unit { int pm, pn; };
struct Gemm { const bf16_t* A; const bf16_t* Bt; int M, N, K; };

struct StaticOrder {
    int nM, nN, nwg, G, c;
    __host__ __device__ void init(int M, int N, int G_, int c_) { nM = M / BM; nN = N / BM; nwg = nM * nN; G = G_; c = c_; }
    __host__ __device__ bool next(int i, Unit& u) const {
        const long L = (long)i * G + c; if (L >= nwg) return false;
        int wgid = (int)L; { const int q = nwg / NXCD, r = nwg % NXCD, xcd = wgid % NXCD, off = wgid / NXCD; wgid = (xcd < r ? xcd * (q + 1) : r * (q + 1) + (xcd - r) * q) + off; }
        const int nig = WGM * nN, gid = wgid / nig, fm = gid * WGM, gsz = (nM - fm) < WGM ? (nM - fm) : WGM;
        u.pm = fm + ((wgid % nig) % gsz); u.pn = (wgid % nig) / gsz; return true;
    }
    __device__ __forceinline__ void a_ready(const Unit&) const {}
    __device__ __forceinline__ void done(const Unit&) const {}
};
__device__ __forceinline__ unsigned cvt_pk_bf16(float lo, float hi) { unsigned r; asm volatile("v_cvt_pk_bf16_f32 %0, %1, %2" : "=v"(r) : "v"(lo), "v"(hi)); return r; }
typedef float f32x2 __attribute__((ext_vector_type(2)));
template <class Epi, class Sched, bool ALIGN_EPI = false, bool SP2 = false>
__device__ __forceinline__ void gemm_phase(PG8_LAS unsigned char* lds, const Gemm g, const Sched& S, const Epi& E) {
    int tid_ = threadIdx.x; asm volatile("" : "+v"(tid_));
    const int tid = tid_, wid = __builtin_amdgcn_readfirstlane(tid >> 6), lane = tid & 63, wr = wid >> 2, wc = wid & 3, fr = lane & 15, fq = lane >> 4;
    const int K = g.K, nt = K / BK;
    unsigned voffA[2], voffB[2];
#pragma unroll
    for (int i = 0; i < 2; ++i) { int R, C; stage_rc(tid * 16 + i * 8192, R, C); const int Rb = Epi::PERM ? ((R & ~31) + perm32(R & 31)) : R;
        voffA[i] = (unsigned)(R * K + C) * 2u; voffB[i] = (unsigned)(Rb * K + C) * 2u; }
    const size_t kstep = (size_t)(BK * 2);
    const size_t hstep = (size_t)HALF * K * 2;
    const size_t tstep = 2 * hstep;
    const unsigned ldsw = (unsigned)wid * 1024u;
    const int aoff = lds_byte(wr * 64 + fr, fq * 8), boff = lds_byte(wc * 32 + fr, fq * 8);
#define PG8_SA(b, h) (((b) * 2 + (h)) * HTB)
#define PG8_SB(b, h) ((4 + (b) * 2 + (h)) * HTB)
#define PG8_STAGE(bufoff, gbase, voff) do { _Pragma("unroll") for (int _i = 0; _i < 2; ++_i) \
        __builtin_amdgcn_global_load_lds((const unsigned*)((const char*)(gbase) + (voff)[_i]), (PG8_LAS unsigned*)(lds + (bufoff) + ldsw + _i * 8192), 16, 0, 0); } while (0)
#define PG8_LDA(dst, b, h) do { _Pragma("unroll") for (int m = 0; m < 4; ++m) _Pragma("unroll") for (int k = 0; k < 2; ++k) dst[m][k] = *(const PG8_LAS bf16x8*)(lds + PG8_SA(b, h) + aoff + m * 2048 + k * 1024); } while (0)
#define PG8_LDB(dst, b, h) do { _Pragma("unroll") for (int n = 0; n < 2; ++n) _Pragma("unroll") for (int k = 0; k < 2; ++k) dst[n][k] = *(const PG8_LAS bf16x8*)(lds + PG8_SB(b, h) + boff + n * 2048 + k * 1024); } while (0)
#define PG8_MMA(ai, bj, At, Bt) do { __builtin_amdgcn_s_setprio(1); _Pragma("unroll") for (int m = 0; m < 4; ++m) _Pragma("unroll") for (int n = 0; n < 2; ++n) _Pragma("unroll") for (int k = 0; k < 2; ++k) \
        acc[ai][bj][m][n] = __builtin_amdgcn_mfma_f32_16x16x32_bf16(Bt[n][k], At[m][k], acc[ai][bj][m][n], 0, 0, 0); __builtin_amdgcn_s_setprio(0); } while (0)
#define PG8_WAIT_V(n) asm volatile("s_waitcnt vmcnt(" #n ")" ::: "memory")
#define PG8_WAIT_L(n) asm volatile("s_waitcnt lgkmcnt(" #n ")" ::: "memory")
#define PG8_BAR __builtin_amdgcn_s_barrier()
#define PG8_SCHED __builtin_amdgcn_sched_barrier(0)
    Unit cur, nxt; int ui = 0;
    if (!S.next(0, cur)) return;
    f32x4 acc[2][2][4][2];
#pragma unroll
    for (int a = 0; a < 2; ++a)
#pragma unroll
        for (int b = 0; b < 2; ++b)
#pragma unroll
            for (int m = 0; m < 4; ++m)
#pragma unroll
                for (int n = 0; n < 2; ++n) acc[a][b][m][n] = (f32x4){0.f, 0.f, 0.f, 0.f};
    bf16x8 At[4][2], B0[2][2], B1[2][2];
    const char* cA = (const char*)g.A + (size_t)cur.pm * tstep; const char* cB = (const char*)g.Bt + (size_t)cur.pn * tstep;
    S.a_ready(cur);
    if constexpr (SP2) {
        PG8_STAGE(PG8_SB(0, 0), cB, voffB); PG8_STAGE(PG8_SB(0, 1), cB + hstep, voffB); PG8_STAGE(PG8_SA(0, 0), cA, voffA); PG8_STAGE(PG8_SA(0, 1), cA + hstep, voffA);
        if (wr == 1) PG8_BAR;
        PG8_WAIT_V(2); PG8_BAR;
        PG8_STAGE(PG8_SB(1, 0), cB + kstep, voffB); PG8_STAGE(PG8_SA(1, 0), cA + kstep, voffA); PG8_STAGE(PG8_SB(1, 1), cB + hstep + kstep, voffB);
        PG8_WAIT_V(6); PG8_BAR;
    } else {
        PG8_STAGE(PG8_SB(0, 0), cB, voffB); PG8_STAGE(PG8_SA(0, 0), cA, voffA); PG8_STAGE(PG8_SB(0, 1), cB + hstep, voffB); PG8_STAGE(PG8_SA(0, 1), cA + hstep, voffA);
        if (wr == 1) PG8_BAR;
        PG8_WAIT_V(4); PG8_BAR;
        PG8_STAGE(PG8_SB(1, 0), cB + kstep, voffB); PG8_STAGE(PG8_SA(1, 0), cA + kstep, voffA); PG8_STAGE(PG8_SB(1, 1), cB + hstep + kstep, voffB);
        PG8_WAIT_V(6); PG8_BAR;
    }
    for (;;) {
        const bool has_next = S.next(ui + 1, nxt);
        const char* nA = has_next ? (const char*)g.A + (size_t)nxt.pm * tstep : cA; const char* nB = has_next ? (const char*)g.Bt + (size_t)nxt.pn * tstep : cB;
        for (int t = 0; t < nt; t += 2) {
            const bool last = (t == nt - 2);
            const char* a1 = cA + (size_t)(t + 1) * kstep;
            const char* a2 = last ? nA : cA + (size_t)(t + 2) * kstep; const char* b2 = last ? nB : cB + (size_t)(t + 2) * kstep;
            const char* a3 = a2 + kstep; const char* b3 = b2 + kstep;
            if (last && has_next) S.a_ready(nxt);
            if constexpr (SP2) {
            PG8_LDB(B0, 0, 0); PG8_LDB(B1, 0, 1); PG8_SCHED; PG8_LDA(At, 0, 0); PG8_STAGE(PG8_SA(1, 1), a1 + hstep, voffA);
            PG8_WAIT_V(8); PG8_WAIT_L(0); PG8_BAR; PG8_MMA(0, 0, At, B0); PG8_MMA(0, 1, At, B1); PG8_BAR; PG8_SCHED;
            PG8_LDA(At, 0, 1); PG8_STAGE(PG8_SB(0, 0), b2, voffB); PG8_STAGE(PG8_SB(0, 1), b2 + hstep, voffB); PG8_STAGE(PG8_SA(0, 0), a2, voffA);
            PG8_WAIT_V(8); PG8_WAIT_L(0); PG8_BAR; PG8_MMA(1, 0, At, B0); PG8_MMA(1, 1, At, B1); PG8_BAR; PG8_SCHED;
            PG8_LDB(B0, 1, 0); PG8_LDB(B1, 1, 1); PG8_SCHED; PG8_LDA(At, 1, 0); PG8_STAGE(PG8_SA(0, 1), a2 + hstep, voffA);
            PG8_WAIT_V(8); PG8_WAIT_L(0); PG8_BAR; PG8_MMA(0, 0, At, B0); PG8_MMA(0, 1, At, B1); PG8_BAR; PG8_SCHED;
            PG8_LDA(At, 1, 1); PG8_STAGE(PG8_SB(1, 0), b3, voffB); PG8_STAGE(PG8_SB(1, 1), b3 + hstep, voffB); PG8_STAGE(PG8_SA(1, 0), a3, voffA);
            PG8_WAIT_V(8); PG8_WAIT_L(0); PG8_BAR; PG8_MMA(1, 0, At, B0); PG8_MMA(1, 1, At, B1); PG8_BAR; PG8_SCHED;
            } else {
            PG8_LDB(B0, 0, 0); PG8_SCHED; PG8_LDA(At, 0, 0); PG8_STAGE(PG8_SA(1, 1), a1 + hstep, voffA);
            PG8_WAIT_L(8); PG8_BAR; PG8_WAIT_L(0); PG8_MMA(0, 0, At, B0); PG8_BAR; PG8_SCHED;
            PG8_LDB(B1, 0, 1); PG8_STAGE(PG8_SB(0, 0), b2, voffB);
            PG8_BAR; PG8_WAIT_L(0); PG8_MMA(0, 1, At, B1); PG8_BAR;
            PG8_LDA(At, 0, 1); PG8_STAGE(PG8_SA(0, 0), a2, voffA);
            PG8_BAR; PG8_WAIT_L(0); PG8_MMA(1, 0, At, B0); PG8_BAR; PG8_SCHED;
            PG8_STAGE(PG8_SB(0, 1), b2 + hstep, voffB);
            PG8_WAIT_V(6); PG8_BAR; PG8_MMA(1, 1, At, B1); PG8_BAR;
            PG8_LDB(B0, 1, 0); PG8_SCHED; PG8_LDA(At, 1, 0); PG8_STAGE(PG8_SA(0, 1), a2 + hstep, voffA);
            PG8_WAIT_L(8); PG8_BAR; PG8_WAIT_L(0); PG8_MMA(0, 0, At, B0); PG8_BAR; PG8_SCHED;
            PG8_LDB(B1, 1, 1); PG8_STAGE(PG8_SB(1, 0), b3, voffB);
            PG8_BAR; PG8_WAIT_L(0); PG8_MMA(0, 1, At, B1); PG8_BAR;
            PG8_LDA(At, 1, 1); PG8_STAGE(PG8_SA(1, 0), a3, voffA);
            PG8_BAR; PG8_WAIT_L(0); PG8_MMA(1, 0, At, B0); PG8_BAR; PG8_SCHED;
            PG8_STAGE(PG8_SB(1, 1), b3 + hstep, voffB);
            PG8_WAIT_V(6); PG8_BAR; PG8_MMA(1, 1, At, B1); PG8_BAR;
            }
        }
        if constexpr (ALIGN_EPI) { if (wr == 0) PG8_BAR; }
        if constexpr (!Epi::AFTER_DRAIN) { E(acc, cur, wr, wc, fr, fq); S.done(cur); }
        if (!has_next) break;
#pragma unroll
        for (int a = 0; a < 2; ++a)
#pragma unroll
            for (int b = 0; b < 2; ++b)
#pragma unroll
                for (int m = 0; m < 4; ++m)
#pragma unroll
                    for (int n = 0; n < 2; ++n) acc[a][b][m][n] = (f32x4){0.f, 0.f, 0.f, 0.f};
        cur = nxt; cA = nA; cB = nB; ++ui;
        if constexpr (ALIGN_EPI) { if (wr == 1) PG8_BAR; }
    }
    PG8_WAIT_V(0);
    if constexpr (!ALIGN_EPI) { if (wr == 0) PG8_BAR; }
    PG8_BAR;
    if constexpr (Epi::AFTER_DRAIN) { E.fused(acc, cur, wr, wc, fr, fq, lds, wid, lane); S.done(cur); }
#undef PG8_SA
#undef PG8_SB
#undef PG8_STAGE
#undef PG8_LDA
#undef PG8_LDB
#undef PG8_MMA
#undef PG8_WAIT_V
#undef PG8_WAIT_L
#undef PG8_BAR
#undef PG8_SCHED
}
constexpr float SC128 = 0.12751743082459868f;
constexpr float SC64  = 0.18033688011112042f;
constexpr int LDP = 6144, LDH = 5632, LDX = 2048;
typedef float f32x2 __attribute__((ext_vector_type(2)));

struct EpiProj {
    static constexpr bool PERM = true, AFTER_DRAIN = false;
    bf16_t* O; const f32x2* tabD; const f32x2* tabL;
    __device__ __forceinline__ void operator()(const f32x4 (&acc)[2][2][4][2], const Unit& u, int wr, int wc, int fr, int fq) const {
        const int pn = u.pn;
        int kind = 0; float sc = 1.f;
        if (pn < 2) sc = SC128;
        else if (pn >= 6 && pn < 10) { kind = 1; if (pn < 8) sc = SC64; }
        else if (pn >= 12 && pn < 20) { kind = 2; if (pn < 16) sc = SC128; }
        const int row0 = u.pm * BM + wr * 64 + fr;
        const int cl = wc * 32 + 8 * fq;
        const bool ropeD = (kind == 1) && ((wc & 1) == 0) && (fq < 2);
        const bool ropeL = (kind == 2) && (wc == 0);
        const bool rope = ropeD || ropeL;
        const int i0 = 4 * fq;
#pragma unroll
        for (int ai = 0; ai < 2; ++ai)
#pragma unroll
            for (int m = 0; m < 4; ++m) {
                const int row = row0 + ai * HALF + m * 16;
                f32x4 cs0 = (f32x4){1.f, 0.f, 1.f, 0.f}, cs1 = (f32x4){1.f, 0.f, 1.f, 0.f};
                if (ropeD) { const f32x4* t = (const f32x4*)(tabD + (size_t)row * 8 + i0); cs0 = t[0]; cs1 = t[1]; }
                else if (ropeL) { const f32x4* t = (const f32x4*)(tabL + (size_t)row * 16 + i0); cs0 = t[0]; cs1 = t[1]; }
                bf16_t* rowp = O + (size_t)row * LDP + pn * BM + cl;
#pragma unroll
                for (int bj = 0; bj < 2; ++bj) {
                    f32x4 v0 = acc[ai][bj][m][0], v1 = acc[ai][bj][m][1];
                    if (rope) {
                        f32x4 w0, w1;
                        w0[0] = v0[0] * cs0[0] - v0[1] * cs0[1]; w0[1] = v0[1] * cs0[0] + v0[0] * cs0[1];
                        w0[2] = v0[2] * cs0[2] - v0[3] * cs0[3]; w0[3] = v0[3] * cs0[2] + v0[2] * cs0[3];
                        w1[0] = v1[0] * cs1[0] - v1[1] * cs1[1]; w1[1] = v1[1] * cs1[0] + v1[0] * cs1[1];
                        w1[2] = v1[2] * cs1[2] - v1[3] * cs1[3]; w1[3] = v1[3] * cs1[2] + v1[2] * cs1[3];
                        v0 = w0; v1 = w1;
                    }
                    v0 = v0 * sc; v1 = v1 * sc;
                    u32x4 w; w.x = cvt_pk_bf16(v0[0], v0[1]); w.y = cvt_pk_bf16(v0[2], v0[3]); w.z = cvt_pk_bf16(v1[0], v1[1]); w.w = cvt_pk_bf16(v1[2], v1[3]);
                    *(u32x4*)(rowp + bj * HALF) = w;
                }
            }
    }
};

struct EpiSwiglu {
    static constexpr bool PERM = true, AFTER_DRAIN = false;
    bf16_t* O;
    __device__ __forceinline__ float act(float g, float u) const {
        const float e = __builtin_amdgcn_exp2f(-1.4426950408889634f * g);
        return g * u * __builtin_amdgcn_rcpf(1.0f + e);
    }
    __device__ __forceinline__ void operator()(const f32x4 (&acc)[2][2][4][2], const Unit& u, int wr, int wc, int fr, int fq) const {
        const int row0 = u.pm * BM + wr * 64 + fr;
        const int col0 = u.pn * HALF + wc * 32 + 8 * fq;
#pragma unroll
        for (int ai = 0; ai < 2; ++ai)
#pragma unroll
            for (int m = 0; m < 4; ++m) {
                bf16_t* rowp = O + (size_t)(row0 + ai * HALF + m * 16) * LDH + col0;
                const f32x4 g0 = acc[ai][0][m][0], g1 = acc[ai][0][m][1], u0 = acc[ai][1][m][0], u1 = acc[ai][1][m][1];
                u32x4 w;
                w.x = cvt_pk_bf16(act(g0[0], u0[0]), act(g0[1], u0[1])); w.y = cvt_pk_bf16(act(g0[2], u0[2]), act(g0[3], u0[3]));
                w.z = cvt_pk_bf16(act(g1[0], u1[0]), act(g1[1], u1[1])); w.w = cvt_pk_bf16(act(g1[2], u1[2]), act(g1[3], u1[3]));
                *(u32x4*)rowp = w;
            }
    }
};

struct EpiResid {
    static constexpr bool PERM = false, AFTER_DRAIN = false;
    const float* base; float* out;
    __device__ __forceinline__ void operator()(const f32x4 (&acc)[2][2][4][2], const Unit& u, int wr, int wc, int fr, int fq) const {
        const int row0 = u.pm * BM + wr * 64 + fr;
        const int col0 = u.pn * BM + wc * 32 + 4 * fq;
#pragma unroll
        for (int ai = 0; ai < 2; ++ai)
#pragma unroll
            for (int m = 0; m < 4; ++m) {
                const size_t off = (size_t)(row0 + ai * HALF + m * 16) * LDX + col0;
#pragma unroll
                for (int bj = 0; bj < 2; ++bj)
#pragma unroll
                    for (int n = 0; n < 2; ++n) {
                        const f32x4 b = *(const f32x4*)(base + off + bj * HALF + n * 16);
                        *(f32x4*)(out + off + bj * HALF + n * 16) = b + acc[ai][bj][m][n];
                    }
            }
    }
};
}
#define LAS __attribute__((address_space(3)))
typedef unsigned short bf16_t;
typedef short bf16x8 __attribute__((ext_vector_type(8)));
typedef short v4i16_t __attribute__((ext_vector_type(4)));
typedef float f32x2 __attribute__((ext_vector_type(2)));
typedef float f32x4 __attribute__((ext_vector_type(4)));
typedef float f32x16 __attribute__((ext_vector_type(16)));
typedef unsigned u32x2 __attribute__((ext_vector_type(2)));
typedef unsigned u32x4 __attribute__((ext_vector_type(4)));
typedef __bf16 bf16x2_t __attribute__((ext_vector_type(2)));

constexpr int BATCH = 2, SEQ = 4096, DM = 2048, DEPTH = 2, MROWS = BATCH * SEQ;
constexpr int NPROJ = 6144, DFF = 5632, NGU = 2 * DFF;
constexpr int LDP = NPROJ;
constexpr float NORM_EPS = 1e-6f;
constexpr int NTHREADS = 512, NWAVES = 8;

constexpr size_t MiB = 1u << 20;
constexpr size_t WS_CTL = 0;
constexpr size_t WS_TAB = 1 * MiB;
constexpr size_t WS_WIN = 4 * MiB;
constexpr size_t WS_WOUT = WS_WIN + 48 * MiB;
constexpr size_t WS_WGU = WS_WOUT + 16 * MiB;
constexpr size_t WS_WDN = WS_WGU + 88 * MiB;
constexpr size_t WS_XN = WS_WDN + 44 * MiB;
constexpr size_t WS_PROJ = WS_XN + 32 * MiB;
constexpr size_t WS_MIX = WS_PROJ + 96 * MiB;
constexpr size_t WS_DIFFO = WS_MIX + 32 * MiB;
constexpr size_t WS_END = WS_DIFFO + 32 * MiB;

constexpr int LDS_RING = 131072, LDS_BYTES = LDS_RING + 256;

__constant__ float INVF[24] = {
    1.000000000e+00f, 1.939227432e-01f, 3.760603070e-02f, 7.292664610e-03f, 1.414213562e-03f, 2.742481884e-04f, 5.318295734e-05f, 1.031338525e-05f,
    1.000000000e+00f, 4.403665960e-01f, 1.939227432e-01f, 8.539710194e-02f, 3.760603070e-02f, 1.656044088e-02f, 7.292664610e-03f, 3.211446106e-03f,
    1.414213562e-03f, 6.227724371e-04f, 2.742481884e-04f, 1.207697351e-04f, 5.318295734e-05f, 2.341999971e-05f, 1.031338525e-05f, 4.541670478e-06f};

__device__ __forceinline__ unsigned f2bf(float f) { unsigned u = __builtin_bit_cast(unsigned, f); return (u + 0x7fffu + ((u >> 16) & 1u)) >> 16; }
__device__ __forceinline__ unsigned pk2(float lo, float hi) { return f2bf(lo) | (f2bf(hi) << 16); }
__device__ __forceinline__ unsigned cvtpk(float lo, float hi) { f32x2 v = {lo, hi}; bf16x2_t b = __builtin_convertvector(v, bf16x2_t); return __builtin_bit_cast(unsigned, b); }
__device__ __forceinline__ float wave_sum(float v) {
#pragma unroll
    for (int o = 1; o < 64; o <<= 1) v += __shfl_xor(v, o);
    return v;
}
__device__ __forceinline__ int crow(int r, int hi) { return (r & 3) + 8 * (r >> 2) + 4 * hi; }
#define LDS_WAIT() asm volatile("s_waitcnt lgkmcnt(0)" ::: "memory")
#define CFENCE() asm volatile("" ::: "memory")

__device__ __forceinline__ void sincos_acc(float x, float& s, float& c) {
    const double xd = (double)x;
    const double kd = __builtin_rint(xd * 0.63661977236758134308);
    double r = __builtin_fma(-kd, 1.57079632679489655800e+00, xd);
    r = __builtin_fma(-kd, 6.12323399573676603587e-17, r);
    const long long k = (long long)kd;
    const double r2 = r * r;
    const double sp = r * (1.0 + r2 * (-1.0 / 6.0 + r2 * (1.0 / 120.0 + r2 * (-1.0 / 5040.0 + r2 * (1.0 / 362880.0 + r2 * (-1.0 / 39916800.0 + r2 * (1.0 / 6227020800.0)))))));
    const double cp = 1.0 + r2 * (-0.5 + r2 * (1.0 / 24.0 + r2 * (-1.0 / 720.0 + r2 * (1.0 / 40320.0 + r2 * (-1.0 / 3628800.0 + r2 * (1.0 / 479001600.0 + r2 * (-1.0 / 87178291200.0)))))));
    const int qd = (int)(k & 3);
    const double sv = (qd == 0) ? sp : (qd == 1) ? cp : (qd == 2) ? -sp : -cp;
    const double cv = (qd == 0) ? cp : (qd == 1) ? -sp : (qd == 2) ? -cp : sp;
    s = (float)sv; c = (float)cv;
}

__device__ __forceinline__ void tr_item(const float* __restrict__ W, int K, int N, int sc0, int permkind, bf16_t* __restrict__ WT, int dr0, int k0, LAS float* scr, int lane) {
    const int j = lane & 31; int pj = j;
    if (permkind == 1) { if (j < 16) pj = (j >> 1) + 8 * (j & 1); }
    else if (permkind == 2) pj = (j >> 1) + 16 * (j & 1);
    const float* src = W + (size_t)k0 * N + sc0 + pj;
#pragma unroll 8
    for (int i = 0; i < 32; ++i) { const int kk = 2 * i + (lane >> 5); scr[kk * 33 + j] = src[(size_t)kk * N]; }
    LDS_WAIT();
    const int c = lane & 7;
#pragma unroll
    for (int jj = 0; jj < 4; ++jj) { const int n = (lane >> 3) + 8 * jj; const LAS float* s = scr + (8 * c) * 33 + n;
        u32x4 o; o.x = pk2(s[0 * 33], s[1 * 33]); o.y = pk2(s[2 * 33], s[3 * 33]); o.z = pk2(s[4 * 33], s[5 * 33]); o.w = pk2(s[6 * 33], s[7 * 33]);
        *(u32x4*)(WT + (size_t)(dr0 + n) * K + k0 + 8 * c) = o; }
    LDS_WAIT();
}

__device__ __forceinline__ void rms_rows_bf16(const float* src, const float* __restrict__ g, bf16_t* dst, int gw, int ngw, int lane) {
    for (int m = gw; m < MROWS; m += ngw) {
        const f32x4* xr = (const f32x4*)(src + (size_t)m * DM) + lane;
        f32x4 v[8]; float ss = 0.f;
#pragma unroll
        for (int j = 0; j < 8; ++j) { v[j] = xr[64 * j]; ss += (v[j].x * v[j].x + v[j].y * v[j].y) + (v[j].z * v[j].z + v[j].w * v[j].w); }
        const float rstd = 1.0f / sqrtf(wave_sum(ss) * (1.0f / DM) + NORM_EPS);
        u32x2* o8 = (u32x2*)(dst + (size_t)m * DM) + lane;
#pragma unroll
        for (int j = 0; j < 8; ++j) { const f32x4 gv = ((const f32x4*)g)[lane + 64 * j]; const f32x4 y = v[j] * rstd * gv;
            u32x2 w; w.x = pk2(y.x, y.y); w.y = pk2(y.z, y.w); o8[64 * j] = w; }
    }
}
__device__ __forceinline__ void rms_rows_f32_inplace(float* buf, const float* __restrict__ g, int gw, int ngw, int lane) {
    for (int m = gw; m < MROWS; m += ngw) {
        f32x4* xr = (f32x4*)(buf + (size_t)m * DM) + lane;
        f32x4 v[8]; float ss = 0.f;
#pragma unroll
        for (int j = 0; j < 8; ++j) { v[j] = xr[64 * j]; ss += (v[j].x * v[j].x + v[j].y * v[j].y) + (v[j].z * v[j].z + v[j].w * v[j].w); }
        const float rstd = 1.0f / sqrtf(wave_sum(ss) * (1.0f / DM) + NORM_EPS);
#pragma unroll
        for (int j = 0; j < 8; ++j) { const f32x4 gv = ((const f32x4*)g)[lane + 64 * j]; xr[64 * j] = v[j] * rstd * gv; }
    }
}

constexpr int VRS = 320;
template <int NDS>
__device__ __forceinline__ f32x16 qk_lds(LAS const unsigned char* kl  , const bf16x8 (&qf)[NDS]) {
    f32x16 s = {};
#pragma unroll
    for (int ds = 0; ds < NDS; ++ds) { const bf16x8 kf = *(LAS const bf16x8*)(kl + 32 * ds); s = __builtin_amdgcn_mfma_f32_32x32x16_bf16(kf, qf[ds], s, 0, 0, 0); }
    return s;
}
__device__ __forceinline__ bf16x8 pack8(const f32x16& p, int b) {
    u32x4 w; w.x = cvtpk(p[b + 0], p[b + 1]); w.y = cvtpk(p[b + 2], p[b + 3]); w.z = cvtpk(p[b + 4], p[b + 5]); w.w = cvtpk(p[b + 6], p[b + 7]);
    return __builtin_bit_cast(bf16x8, w);
}
__device__ __forceinline__ v4i16_t vtr(LAS const unsigned char* p) { return __builtin_amdgcn_ds_read_tr16_b64_v4i16((LAS v4i16_t*)p); }
__device__ __forceinline__ void pv_accum(f32x16 (&o)[4], LAS const unsigned char* vlane, const f32x16& p) {
    const bf16x8 pb0 = pack8(p, 0), pb1 = pack8(p, 8);
#pragma unroll
    for (int db = 0; db < 4; ++db) {
        const v4i16_t a0 = vtr(vlane + db * 64), a1 = vtr(vlane + db * 64 + 8 * VRS);
        const v4i16_t b0 = vtr(vlane + db * 64 + 16 * VRS), b1 = vtr(vlane + db * 64 + 24 * VRS);
        const bf16x8 v0 = (bf16x8){a0[0], a0[1], a0[2], a0[3], a1[0], a1[1], a1[2], a1[3]};
        const bf16x8 v1 = (bf16x8){b0[0], b0[1], b0[2], b0[3], b1[0], b1[1], b1[2], b1[3]};
        o[db] = __builtin_amdgcn_mfma_f32_32x32x16_bf16(v0, pb0, o[db], 0, 0, 0);
        o[db] = __builtin_amdgcn_mfma_f32_32x32x16_bf16(v1, pb1, o[db], 0, 0, 0);
    }
}
__device__ __forceinline__ void softmax_step(f32x16& s, float& m, float& lsum, f32x16 (&o)[4]) {
    float mx = s[0];
#pragma unroll
    for (int r = 1; r < 16; ++r) mx = fmaxf(mx, s[r]);
    mx = fmaxf(mx, __shfl_xor(mx, 32));
    if (__any(mx > m)) {
        const float mnew = fmaxf(m, mx); const float alpha = __builtin_amdgcn_exp2f(m - mnew); m = mnew;
        lsum *= alpha;
#pragma unroll
        for (int db = 0; db < 4; ++db) o[db] = o[db] * alpha;
    }
    float ps = 0.f;
#pragma unroll
    for (int r = 0; r < 16; ++r) { s[r] = __builtin_amdgcn_exp2f(s[r] - m); ps += s[r]; }
    lsum += ps;
}
__device__ __forceinline__ void head_norm_store(bf16_t* dst, const f32x16 (&o)[4], float pre, const float* __restrict__ g, float mult, int h) {
    float ss = 0.f;
#pragma unroll
    for (int db = 0; db < 4; ++db)
#pragma unroll
        for (int r = 0; r < 16; ++r) { const float v = o[db][r] * pre; ss += v * v; }
    ss += __shfl_xor(ss, 32);
    const float sc = pre * mult / sqrtf(ss * (1.0f / 128.0f) + NORM_EPS);
#pragma unroll
    for (int db = 0; db < 4; ++db)
#pragma unroll
        for (int a = 0; a < 4; ++a) { const int d0 = 32 * db + 8 * a + 4 * h; const f32x4 gv = *(const f32x4*)(g + d0);
            u32x2 w; w.x = cvtpk(o[db][4 * a + 0] * sc * gv.x, o[db][4 * a + 1] * sc * gv.y); w.y = cvtpk(o[db][4 * a + 2] * sc * gv.z, o[db][4 * a + 3] * sc * gv.w);
            *(u32x2*)(dst + d0) = w; }
}

template <int MODE>
__device__ __forceinline__ void causal_unit(const bf16_t* __restrict__ P, int b, int qb, int qcol, int kcol, int vcol, LAS unsigned char* lds, int tid, int wid, int lane,
                                            f32x16 (&o)[4], float& lsum_out) {
    constexpr int DQK = MODE == 0 ? 128 : 64, NDS = DQK / 16, KRS = DQK * 2 + 16, KBUF = 64 * KRS, VBUF = 64 * VRS, CPRK = DQK / 8, NKL = (64 * CPRK) / NTHREADS;
    const int q = lane & 31, h = lane >> 5;
    const size_t rb = (size_t)b * SEQ;
    const int q0 = qb * 256, qw0 = q0 + 32 * wid, qpos = qw0 + q;
    bf16x8 qf[NDS];
#pragma unroll
    for (int ds = 0; ds < NDS; ++ds) qf[ds] = *(const bf16x8*)(P + (rb + qpos) * LDP + qcol + 16 * ds + 8 * h);
#pragma unroll
    for (int db = 0; db < 4; ++db) o[db] = (f32x16){};
    float m = -1e30f, lsum = 0.f, carry = 0.f;
    bf16x8 T0, T1;
#pragma unroll
    for (int j = 0; j < 8; ++j) { const int kv = 8 * (j >> 2) + 4 * h + (j & 3); T0[j] = (kv > q) ? (short)0x3F80 : (short)0; T1[j] = (16 + kv > q) ? (short)0x3F80 : (short)0; }
    const int NT = 4 * (qb + 1);
    static_assert(NKL == 1 || CPRK == 16, "second K piece = +32 rows");
    const int kgo = (tid / CPRK) * LDP + kcol + 8 * (tid % CPRK), klo = (tid / CPRK) * KRS + 16 * (tid % CPRK);
    const int vgo = (tid >> 4) * LDP + vcol + 8 * (tid & 15), vlo = 2 * KBUF + (tid >> 4) * VRS + 16 * (tid & 15);
    u32x4 kr[NKL], vr[2];
#define CU_GLOAD(t) do { const bf16_t* p0_ = P + (rb + 64 * (size_t)(t)) * LDP; \
        _Pragma("unroll") for (int i = 0; i < NKL; ++i) kr[i] = *(const u32x4*)(p0_ + kgo + i * 32 * LDP); \
        _Pragma("unroll") for (int i = 0; i < 2; ++i) vr[i] = *(const u32x4*)(p0_ + vgo + i * 32 * LDP); } while (0)
#define CU_LSTORE(buf) do { \
        _Pragma("unroll") for (int i = 0; i < NKL; ++i) *(LAS u32x4*)(lds + (buf) * KBUF + klo + i * 32 * KRS) = kr[i]; \
        _Pragma("unroll") for (int i = 0; i < 2; ++i) *(LAS u32x4*)(lds + (buf) * VBUF + vlo + i * 32 * VRS) = vr[i]; } while (0)
    const int g16 = lane >> 4, i16 = lane & 15;
    const int vlane_off = (4 * h + (i16 >> 2)) * VRS + (16 * (g16 & 1) + 4 * (i16 & 3)) * 2;
    const int klane_off = q * KRS + 16 * h;
    CU_GLOAD(NT - 1); CU_LSTORE(0); __syncthreads();
    for (int it = 0; it < NT; ++it) {
        const int t = NT - 1 - it, buf = it & 1;
        if (it + 1 < NT) CU_GLOAD(t - 1);
        const int kv0 = 64 * t;
#pragma unroll
        for (int sub = 1; sub >= 0; --sub) {
            const int kvs0 = kv0 + 32 * sub;
            if (kvs0 <= qw0) {
                const bool diag = (kvs0 == qw0);
                LAS const unsigned char* kl = lds + buf * KBUF + 32 * sub * KRS + klane_off;
                LAS const unsigned char* vl = lds + 2 * KBUF + buf * VBUF + 32 * sub * VRS + vlane_off;
                f32x16 s = qk_lds<NDS>(kl, qf);
                if (MODE == 1) {
                    if (diag) {
#pragma unroll
                        for (int r = 0; r < 16; ++r) if (kvs0 + crow(r, h) > qpos) s[r] = -INFINITY;
                    }
                    softmax_step(s, m, lsum, o);
                } else {
                    f32x16 sp;
                    float tot = 0.f;
#pragma unroll
                    for (int r = 0; r < 16; ++r) {
                        const float z = s[r];
                        const float e = __builtin_amdgcn_exp2f(-fabsf(z));
                        float v = fmaxf(z, 0.f) + __builtin_amdgcn_logf(1.0f + e);
                        if (diag && !(kvs0 + crow(r, h) < qpos)) v = 0.f;
                        sp[r] = v; tot += v;
                    }
                    tot += __shfl_xor(tot, 32);
                    f32x16 w = {};
                    w = __builtin_amdgcn_mfma_f32_32x32x16_bf16(T0, pack8(sp, 0), w, 0, 0, 0);
                    w = __builtin_amdgcn_mfma_f32_32x32x16_bf16(T1, pack8(sp, 8), w, 0, 0, 0);
#pragma unroll
                    for (int r = 0; r < 16; ++r) {
                        float a = __builtin_amdgcn_exp2f(s[r] - sp[r] - w[r] - carry);
                        if (diag && !(kvs0 + crow(r, h) < qpos)) a = 0.f;
                        s[r] = a;
                    }
                    carry += tot;
                }
                pv_accum(o, vl, s);
            }
        }
        if (it + 1 < NT) CU_LSTORE(buf ^ 1);
        __syncthreads();
    }
#undef CU_GLOAD
#undef CU_LSTORE
    lsum_out = lsum + __shfl_xor(lsum, 32);
}

__device__ __forceinline__ void dilated_task(const bf16_t* __restrict__ P, int id, LAS unsigned char* vlds, int lane, bf16_t* MIX, const float* __restrict__ gdil) {
    const int c = id & 15, g = (id >> 4) & 7, head = (id >> 7) & 7, b = id >> 10;
    const int q = lane & 31, h = lane >> 5;
    const size_t rb = (size_t)b * SEQ;
    const int qpos = 512 * g + c + 16 * q, Ttop = 512 * g + c + 496;
    const int qcol = 3072 + head * 128, kcol = 4096 + head * 128, vcol = 5120 + head * 128;
    bf16x8 qf[8];
#pragma unroll
    for (int ds = 0; ds < 8; ++ds) qf[ds] = *(const bf16x8*)(P + (rb + qpos) * LDP + qcol + 16 * ds + 8 * h);
    f32x16 o[4];
#pragma unroll
    for (int db = 0; db < 4; ++db) o[db] = (f32x16){};
    float m = -1e30f, lsum = 0.f;
    const int g16 = lane >> 4, i16 = lane & 15;
    LAS const unsigned char* vl = vlds + (4 * h + (i16 >> 2)) * VRS + (16 * (g16 & 1) + 4 * (i16 & 3)) * 2;
    for (int pat = 0; pat < 3; ++pat) {
        const int rr = pat == 0 ? 16 : (pat == 1 ? 4 : 1);
        const int ww = pat == 0 ? 2048 : (pat == 1 ? 512 : 128);
        const int nsub = pat == 0 ? 5 : (pat == 1 ? 8 : 20);
        for (int j = 0; j < nsub; ++j) {
            const int n0 = 32 * j;
            bf16x8 kf[8];
            { int pos = Ttop - rr * (n0 + q); pos = pos < 0 ? 0 : pos; const bf16_t* kp = P + (rb + pos) * LDP + kcol + 8 * h;
#pragma unroll
              for (int ds = 0; ds < 8; ++ds) kf[ds] = *(const bf16x8*)(kp + 16 * ds); }
            u32x4 vv[8];
#pragma unroll
            for (int i = 0; i < 8; ++i) { int pos = Ttop - rr * (n0 + 4 * i + g16); pos = pos < 0 ? 0 : pos; vv[i] = *(const u32x4*)(P + (rb + pos) * LDP + vcol + 8 * i16); }
            CFENCE();
#pragma unroll
            for (int i = 0; i < 8; ++i) *(LAS u32x4*)(vlds + (4 * i + g16) * VRS + 16 * i16) = vv[i];
            CFENCE();
            f32x16 s = {};
#pragma unroll
            for (int ds = 0; ds < 8; ++ds) s = __builtin_amdgcn_mfma_f32_32x32x16_bf16(kf[ds], qf[ds], s, 0, 0, 0);
#pragma unroll
            for (int r = 0; r < 16; ++r) { const int pos = Ttop - rr * (n0 + crow(r, h)); const int dd = qpos - pos; if (!(pos >= 0 && dd >= 0 && dd <= ww)) s[r] = -INFINITY; }
            softmax_step(s, m, lsum, o);
            pv_accum(o, vl, s);
            CFENCE();
        }
    }
    lsum += __shfl_xor(lsum, 32);
    head_norm_store(MIX + (rb + qpos) * DM + 1024 + head * 128, o, 1.0f / lsum, gdil, 1.0f, h);
}

struct Args {
    const float* x; const int* pos; const float* norm_mix_g; const float* w_in; const float* lq1; const float* lk1; const float* lq2; const float* lk2;
    const float* g_sb; const float* g_diff; const float* g_dil; const float* w_out; const float* norm_ffn_g; const float* w_gate; const float* w_up; const float* w_down;
    const float* norm_final_g; float* out; unsigned char* ws;
};

__global__ void __launch_bounds__(NTHREADS, 2) mega_fwd(Args a) {
    extern __shared__ __attribute__((aligned(16))) unsigned char lds_raw[];
    LAS unsigned char* lds = (LAS unsigned char*)lds_raw;
    volatile LAS unsigned* misc = (volatile LAS unsigned*)(lds + LDS_RING);
    cg::grid_group grid = cg::this_grid();
#define FRESH_IDS() int tid = threadIdx.x; asm volatile("" : "+v"(tid)); const int lane = tid & 63, wid = __builtin_amdgcn_readfirstlane(tid >> 6); const int gw = blockIdx.x * NWAVES + wid; (void)lane; (void)gw
    const int G = gridDim.x, ngw = G * NWAVES;
    unsigned char* ws = a.ws;
    unsigned* ctl = (unsigned*)(ws + WS_CTL);
    pg8::f32x2* tabD = (pg8::f32x2*)(ws + WS_TAB);
    pg8::f32x2* tabL = (pg8::f32x2*)(ws + WS_TAB + 512 * 1024);
    bf16_t* XN = (bf16_t*)(ws + WS_XN); bf16_t* PROJ = (bf16_t*)(ws + WS_PROJ); bf16_t* HB = (bf16_t*)(ws + WS_PROJ); bf16_t* MIX = (bf16_t*)(ws + WS_MIX);
    float* DIFFO = (float*)(ws + WS_DIFFO);

    {
        FRESH_IDS();
        LAS float* scr = (LAS float*)(lds + wid * 16384);
        constexpr int I_IN = 32 * 192, I_OUT = 32 * 64, I_GU = 32 * 352, I_DN = 88 * 64, I_L = I_IN + I_OUT + I_GU + I_DN;
        for (int it = gw; it < DEPTH * I_L; it += ngw) {
            const int L = it / I_L; int r = it % I_L;
            if (r < I_IN) { const int kb = r / 192, nb = r % 192, dr0 = 32 * nb; int pk = 0;
                if (dr0 >= 1536 && dr0 < 2560) pk = ((dr0 & 63) == 0) ? 1 : 0; else if (dr0 >= 3072 && dr0 < 5120) pk = ((dr0 & 127) == 0) ? 2 : 0;
                tr_item(a.w_in + (size_t)L * DM * NPROJ, DM, NPROJ, dr0, pk, (bf16_t*)(ws + WS_WIN) + (size_t)L * NPROJ * DM, dr0, 64 * kb, scr, lane); continue; }
            r -= I_IN;
            if (r < I_OUT) { const int kb = r / 64, nb = r % 64;
                tr_item(a.w_out + (size_t)L * DM * DM, DM, DM, 32 * nb, 0, (bf16_t*)(ws + WS_WOUT) + (size_t)L * DM * DM, 32 * nb, 64 * kb, scr, lane); continue; }
            r -= I_OUT;
            if (r < I_GU) { const int kb = r / 352, nb = r % 352, dr0 = 32 * nb, tile = dr0 >> 8, within = dr0 & 255;
                const float* src = (within >> 7) ? a.w_up : a.w_gate;
                tr_item(src + (size_t)L * DM * DFF, DM, DFF, tile * 128 + (within & 127), 0, (bf16_t*)(ws + WS_WGU) + (size_t)L * NGU * DM, dr0, 64 * kb, scr, lane); continue; }
            r -= I_GU;
            { const int kb = r / 64, nb = r % 64;
              tr_item(a.w_down + (size_t)L * DFF * DM, DFF, DM, 32 * nb, 0, (bf16_t*)(ws + WS_WDN) + (size_t)L * DM * DFF, 32 * nb, 64 * kb, scr, lane); }
        }
        for (int idx = blockIdx.x * NTHREADS + tid; idx < MROWS * 24; idx += G * NTHREADS) {
            const int row = idx / 24, i = idx % 24;
            const float ang = (float)a.pos[row] * INVF[i];
            float s, c; sincos_acc(ang, s, c);
            if (i < 8) tabD[(size_t)row * 8 + i] = (pg8::f32x2){c, s}; else tabL[(size_t)row * 16 + (i - 8)] = (pg8::f32x2){c, s};
        }
        rms_rows_bf16(a.x, a.norm_mix_g, XN, gw, ngw, lane);
    }
    grid.sync();

    for (int L = 0; L < DEPTH; ++L) {
        const float* xin = (L == 0) ? a.x : a.out;
        {
            pg8::Gemm g{XN, (const bf16_t*)(ws + WS_WIN) + (size_t)L * NPROJ * DM, MROWS, NPROJ, DM};
            pg8::StaticOrder S; S.init(MROWS, NPROJ, G, (int)blockIdx.x);
            pg8::EpiProj E{PROJ, tabD, tabL};
            pg8::gemm_phase<pg8::EpiProj, pg8::StaticOrder, true, true>(lds, g, S, E);
        }
        grid.sync();
        {
            FRESH_IDS();
            unsigned* ctr = ctl + 64 * (1 + L);
            const float lambda_init = (L == 0) ? 0.2f : 0.35550906759096934f;
            (void)lambda_init;
            for (;;) {
                __syncthreads();
                if (tid == 0) misc[0] = atomicAdd(ctr, 1u);
                __syncthreads();
                const int idx = (int)misc[0];
                if (idx >= 640) break;
                int kind, qb = 0, k = 0;
                if (idx < 288) { qb = 15 - idx / 24; k = idx % 24; kind = (k < 8) ? 0 : 1; }
                else if (idx < 544) { kind = 2; k = idx - 288; }
                else { const int k2 = idx - 544; qb = 3 - k2 / 24; k = k2 % 24; kind = (k < 8) ? 0 : 1; }
                if (kind == 0) {
                    const int b = k >> 2, head = k & 3;
                    f32x16 o[4]; float ls;
                    causal_unit<0>(PROJ, b, qb, head * 128, 512 + head * 128, 1024 + head * 128, lds, tid, wid, lane, o, ls);
                    const int qpos = qb * 256 + 32 * wid + (lane & 31);
                    head_norm_store(MIX + ((size_t)b * SEQ + qpos) * DM + head * 128, o, 1.0f, a.g_sb + L * 128, 1.0f, lane >> 5);
                } else if (kind == 1) {
                    const int kk = k - 8, comp = kk & 1, b = kk >> 3, head = (kk >> 1) & 3;
                    f32x16 o[4]; float ls;
                    causal_unit<1>(PROJ, b, qb, 1536 + head * 128 + comp * 64, 2048 + head * 128 + comp * 64, 2560 + head * 128, lds, tid, wid, lane, o, ls);
                    const int qpos = qb * 256 + 32 * wid + (lane & 31), h = lane >> 5;
                    const float inv = 1.0f / ls;
                    float* dst = DIFFO + (size_t)comp * MROWS * 512 + ((size_t)b * SEQ + qpos) * 512 + head * 128;
#pragma unroll
                    for (int db = 0; db < 4; ++db)
#pragma unroll
                        for (int aa = 0; aa < 4; ++aa) { const int d0 = 32 * db + 8 * aa + 4 * h;
                            *(f32x4*)(dst + d0) = (f32x4){o[db][4 * aa] * inv, o[db][4 * aa + 1] * inv, o[db][4 * aa + 2] * inv, o[db][4 * aa + 3] * inv}; }
                } else {
                    dilated_task(PROJ, k * 8 + wid, lds + wid * 10240, lane, MIX, a.g_dil + L * 128);
                }
            }
        }
        grid.sync();
        {
            FRESH_IDS();
            const float lambda_init = (L == 0) ? 0.2f : 0.35550906759096934f;
            const float s1 = wave_sum(a.lq1[L * 64 + lane] * a.lk1[L * 64 + lane]), s2 = wave_sum(a.lq2[L * 64 + lane] * a.lk2[L * 64 + lane]);
            const float lam = expf(s1) - expf(s2) + lambda_init;
            const f32x2 gd = *(const f32x2*)(a.g_diff + L * 128 + 2 * lane);
            for (int it = gw; it < MROWS * 4; it += ngw) {
                const int row = it >> 2, head = it & 3;
                const f32x2 o1 = *(const f32x2*)(DIFFO + (size_t)row * 512 + head * 128 + 2 * lane);
                const f32x2 o2 = *(const f32x2*)(DIFFO + (size_t)MROWS * 512 + (size_t)row * 512 + head * 128 + 2 * lane);
                const f32x2 v = o1 - lam * o2;
                const float ss = wave_sum(v.x * v.x + v.y * v.y);
                const float sc = (1.0f - lambda_init) / sqrtf(ss * (1.0f / 128.0f) + NORM_EPS);
                *(unsigned*)(MIX + (size_t)row * DM + 512 + head * 128 + 2 * lane) = pk2(v.x * sc * gd.x, v.y * sc * gd.y);
            }
        }
        grid.sync();
        {
            pg8::Gemm g{MIX, (const bf16_t*)(ws + WS_WOUT) + (size_t)L * DM * DM, MROWS, DM, DM};
            pg8::StaticOrder S; S.init(MROWS, DM, G, (int)blockIdx.x);
            pg8::EpiResid E{xin, a.out};
            pg8::gemm_phase<pg8::EpiResid, pg8::StaticOrder, true, true>(lds, g, S, E);
        }
        grid.sync();
        { FRESH_IDS(); rms_rows_bf16(a.out, a.norm_ffn_g + L * DM, XN, gw, ngw, lane); }
        grid.sync();
        {
            pg8::Gemm g{XN, (const bf16_t*)(ws + WS_WGU) + (size_t)L * NGU * DM, MROWS, NGU, DM};
            pg8::StaticOrder S; S.init(MROWS, NGU, G, (int)blockIdx.x);
            pg8::EpiSwiglu E{HB};
            pg8::gemm_phase<pg8::EpiSwiglu, pg8::StaticOrder, true, true>(lds, g, S, E);
        }
        grid.sync();
        {
            pg8::Gemm g{HB, (const bf16_t*)(ws + WS_WDN) + (size_t)L * DM * DFF, MROWS, DM, DFF};
            pg8::StaticOrder S; S.init(MROWS, DM, G, (int)blockIdx.x);
            pg8::EpiResid E{a.out, a.out};
            pg8::gemm_phase<pg8::EpiResid, pg8::StaticOrder, true, true>(lds, g, S, E);
        }
        grid.sync();
        if (L + 1 < DEPTH) { FRESH_IDS(); rms_rows_bf16(a.out, a.norm_mix_g + (L + 1) * DM, XN, gw, ngw, lane); grid.sync(); }
        else { FRESH_IDS(); rms_rows_f32_inplace(a.out, a.norm_final_g, gw, ngw, lane); }
    }
}

extern "C" void kernel_launch(void* const* d_in, const int* in_sizes, int n_in, void* d_out, int out_size, void* d_ws, size_t ws_size, hipStream_t stream) {
    static int grid = 0;
    if (grid == 0) {
        if (n_in != 17 || out_size != MROWS * DM || ws_size < WS_END) { fprintf(stderr, "kernel_launch: unexpected shapes (n_in %d out %d ws %zu)\n", n_in, out_size, ws_size); grid = -1; return; }
        int dev = 0, cus = 0, per_cu = 0;
        hipGetDevice(&dev); hipDeviceGetAttribute(&cus, hipDeviceAttributeMultiprocessorCount, dev);
        if (hipFuncSetAttribute((const void*)mega_fwd, hipFuncAttributeMaxDynamicSharedMemorySize, LDS_BYTES) != hipSuccess) { fprintf(stderr, "kernel_launch: hipFuncSetAttribute failed\n"); }
        hipOccupancyMaxActiveBlocksPerMultiprocessor(&per_cu, (const void*)mega_fwd, NTHREADS, LDS_BYTES);
        (void)hipGetLastError();
        if (per_cu < 1) { fprintf(stderr, "kernel_launch: occupancy query says %d blocks per CU\n", per_cu); per_cu = 1; }
        grid = cus;
    }
    if (grid < 0) return;
    hipMemsetAsync((char*)d_ws + WS_CTL, 0, 4096, stream);
    Args a{};
    a.x = (const float*)d_in[0]; a.pos = (const int*)d_in[1]; a.norm_mix_g = (const float*)d_in[2]; a.w_in = (const float*)d_in[3];
    a.lq1 = (const float*)d_in[4]; a.lk1 = (const float*)d_in[5]; a.lq2 = (const float*)d_in[6]; a.lk2 = (const float*)d_in[7];
    a.g_sb = (const float*)d_in[8]; a.g_diff = (const float*)d_in[9]; a.g_dil = (const float*)d_in[10]; a.w_out = (const float*)d_in[11];
    a.norm_ffn_g = (const float*)d_in[12]; a.w_gate = (const float*)d_in[13]; a.w_up = (const float*)d_in[14]; a.w_down = (const float*)d_in[15];
    a.norm_final_g = (const float*)d_in[16]; a.out = (float*)d_out; a.ws = (unsigned char*)d_ws;
    void* args[] = {&a};
    hipError_t e = hipLaunchCooperativeKernel((const void*)mega_fwd, dim3(grid), dim3(NTHREADS), args, LDS_BYTES, stream);
    if (e != hipSuccess) fprintf(stderr, "kernel_launch: cooperative launch failed: %s (grid %d)\n", hipGetErrorString(e), grid);
}
```

```cpp
#include <hip/hip_runtime.h>
#include <hip/hip_cooperative_groups.h>
#include <cstdio>
#include <cstdint>
#include <cmath>
namespace cg = cooperative_groups;
namespace pg8 {
#define PG8_LAS __attribute__((address_space(3)))
typedef unsigned short bf16_t;
typedef short bf16x8 __attribute__((ext_vector_type(8)));
typedef float f32x4 __attribute__((ext_vector_type(4)));
typedef unsigned u32x4 __attribute__((ext_vector_type(4)));
constexpr int BM = 256, BK = 64, HALF = 128, HTB = HALF * BK * 2  , STAGE_BYTES = 8 * HTB, NXCD = 8, WGM = 8;

__host__ __device__ __forceinline__ int lds_byte(int r, int c) { const int st = (r >> 4) * 2 + (c >> 5), rr = r & 15, cc = c & 31, ob = rr * 64 + cc * 2; return st * 1024 + (ob ^ (((ob >> 9) & 1) << 5)); }
__host__ __device__ __forceinline__ void stage_rc(int b, int& R, int& C) { const int st = b / 1024, sb = b % 1024, swz = sb ^ (((sb >> 9) & 1) << 5); R = (st >> 1) * 16 + swz / 64; C = (st & 1) * 32 + (swz % 64) / 2; }
__host__ __device__ __forceinline__ int perm32(int rho) { const int n = rho >> 4, i = rho & 15; return 8 * (i >> 2) + 4 * n + (i & 3); }

struct Unit { int pm, pn; };
struct Gemm { const bf16_t* A; const bf16_t* Bt; int M, N, K; };

struct StaticOrder {
    int nM, nN, nwg, G, c;
    __host__ __device__ void init(int M, int N, int G_, int c_) { nM = M / BM; nN = N / BM; nwg = nM * nN; G = G_; c = c_; }
    __host__ __device__ bool next(int i, Unit& u) const {
        const long L = (long)i * G + c; if (L >= nwg) return false;
        int wgid = (int)L; { const int q = nwg / NXCD, r = nwg % NXCD, xcd = wgid % NXCD, off = wgid / NXCD; wgid = (xcd < r ? xcd * (q + 1) : r * (q + 1) + (xcd - r) * q) + off; }
        const int nig = WGM * nN, gid = wgid / nig, fm = gid * WGM, gsz = (nM - fm) < WGM ? (nM - fm) : WGM;
        u.pm = fm + ((wgid % nig) % gsz); u.pn = (wgid % nig) / gsz; return true;
    }
    __device__ __forceinline__ void a_ready(const Unit&) const {}
    __device__ __forceinline__ void done(const Unit&) const {}
};
__device__ __forceinline__ unsigned cvt_pk_bf16(float lo, float hi) { unsigned r; asm volatile("v_cvt_pk_bf16_f32 %0, %1, %2" : "=v"(r) : "v"(lo), "v"(hi)); return r; }
typedef float f32x2 __attribute__((ext_vector_type(2)));
template <class Epi, class Sched, bool ALIGN_EPI = false, bool SP2 = false>
__device__ __forceinline__ void gemm_phase(PG8_LAS unsigned char* lds, const Gemm g, const Sched& S, const Epi& E) {
    int tid_ = threadIdx.x; asm volatile("" : "+v"(tid_));
    const int tid = tid_, wid = __builtin_amdgcn_readfirstlane(tid >> 6), lane = tid & 63, wr = wid >> 2, wc = wid & 3, fr = lane & 15, fq = lane >> 4;
    const int K = g.K, nt = K / BK;
    unsigned voffA[2], voffB[2];
#pragma unroll
    for (int i = 0; i < 2; ++i) { int R, C; stage_rc(tid * 16 + i * 8192, R, C); const int Rb = Epi::PERM ? ((R & ~31) + perm32(R & 31)) : R;
        voffA[i] = (unsigned)(R * K + C) * 2u; voffB[i] = (unsigned)(Rb * K + C) * 2u; }
    const size_t kstep = (size_t)(BK * 2);
    const size_t hstep = (size_t)HALF * K * 2;
    const size_t tstep = 2 * hstep;
    const unsigned ldsw = (unsigned)wid * 1024u;
    const int aoff = lds_byte(wr * 64 + fr, fq * 8), boff = lds_byte(wc * 32 + fr, fq * 8);
#define PG8_SA(b, h) (((b) * 2 + (h)) * HTB)
#define PG8_SB(b, h) ((4 + (b) * 2 + (h)) * HTB)
#define PG8_STAGE(bufoff, gbase, voff) do { _Pragma("unroll") for (int _i = 0; _i < 2; ++_i) \
        __builtin_amdgcn_global_load_lds((const unsigned*)((const char*)(gbase) + (voff)[_i]), (PG8_LAS unsigned*)(lds + (bufoff) + ldsw + _i * 8192), 16, 0, 0); } while (0)
#define PG8_LDA(dst, b, h) do { _Pragma("unroll") for (int m = 0; m < 4; ++m) _Pragma("unroll") for (int k = 0; k < 2; ++k) dst[m][k] = *(const PG8_LAS bf16x8*)(lds + PG8_SA(b, h) + aoff + m * 2048 + k * 1024); } while (0)
#define PG8_LDB(dst, b, h) do { _Pragma("unroll") for (int n = 0; n < 2; ++n) _Pragma("unroll") for (int k = 0; k < 2; ++k) dst[n][k] = *(const PG8_LAS bf16x8*)(lds + PG8_SB(b, h) + boff + n * 2048 + k * 1024); } while (0)
#define PG8_MMA(ai, bj, At, Bt) do { __builtin_amdgcn_s_setprio(1); _Pragma("unroll") for (int m = 0; m < 4; ++m) _Pragma("unroll") for (int n = 0; n < 2; ++n) _Pragma("unroll") for (int k = 0; k < 2; ++k) \
        acc[ai][bj][m][n] = __builtin_amdgcn_mfma_f32_16x16x32_bf16(Bt[n][k], At[m][k], acc[ai][bj][m][n], 0, 0, 0); __builtin_amdgcn_s_setprio(0); } while (0)
#define PG8_WAIT_V(n) asm volatile("s_waitcnt vmcnt(" #n ")" ::: "memory")
#define PG8_WAIT_L(n) asm volatile("s_waitcnt lgkmcnt(" #n ")" ::: "memory")
#define PG8_BAR __builtin_amdgcn_s_barrier()
#define PG8_SCHED __builtin_amdgcn_sched_barrier(0)
    Unit cur, nxt; int ui = 0;
    if (!S.next(0, cur)) return;
    f32x4 acc[2][2][4][2];
#pragma unroll
    for (int a = 0; a < 2; ++a)
#pragma unroll
        for (int b = 0; b < 2; ++b)
#pragma unroll
            for (int m = 0; m < 4; ++m)
#pragma unroll
                for (int n = 0; n < 2; ++n) acc[a][b][m][n] = (f32x4){0.f, 0.f, 0.f, 0.f};
    bf16x8 At[4][2], B0[2][2], B1[2][2];
    const char* cA = (const char*)g.A + (size_t)cur.pm * tstep; const char* cB = (const char*)g.Bt + (size_t)cur.pn * tstep;
    S.a_ready(cur);
    if constexpr (SP2) {
        PG8_STAGE(PG8_SB(0, 0), cB, voffB); PG8_STAGE(PG8_SB(0, 1), cB + hstep, voffB); PG8_STAGE(PG8_SA(0, 0), cA, voffA); PG8_STAGE(PG8_SA(0, 1), cA + hstep, voffA);
        if (wr == 1) PG8_BAR;
        PG8_WAIT_V(2); PG8_BAR;
        PG8_STAGE(PG8_SB(1, 0), cB + kstep, voffB); PG8_STAGE(PG8_SA(1, 0), cA + kstep, voffA); PG8_STAGE(PG8_SB(1, 1), cB + hstep + kstep, voffB);
        PG8_WAIT_V(6); PG8_BAR;
    } else {
        PG8_STAGE(PG8_SB(0, 0), cB, voffB); PG8_STAGE(PG8_SA(0, 0), cA, voffA); PG8_STAGE(PG8_SB(0, 1), cB + hstep, voffB); PG8_STAGE(PG8_SA(0, 1), cA + hstep, voffA);
        if (wr == 1) PG8_BAR;
        PG8_WAIT_V(4); PG8_BAR;
        PG8_STAGE(PG8_SB(1, 0), cB + kstep, voffB); PG8_STAGE(PG8_SA(1, 0), cA + kstep, voffA); PG8_STAGE(PG8_SB(1, 1), cB + hstep + kstep, voffB);
        PG8_WAIT_V(6); PG8_BAR;
    }
    for (;;) {
        const bool has_next = S.next(ui + 1, nxt);
        const char* nA = has_next ? (const char*)g.A + (size_t)nxt.pm * tstep : cA; const char* nB = has_next ? (const char*)g.Bt + (size_t)nxt.pn * tstep : cB;
        for (int t = 0; t < nt; t += 2) {
            const bool last = (t == nt - 2);
            const char* a1 = cA + (size_t)(t + 1) * kstep;
            const char* a2 = last ? nA : cA + (size_t)(t + 2) * kstep; const char* b2 = last ? nB : cB + (size_t)(t + 2) * kstep;
            const char* a3 = a2 + kstep; const char* b3 = b2 + kstep;
            if (last && has_next) S.a_ready(nxt);
            if constexpr (SP2) {
            PG8_LDB(B0, 0, 0); PG8_LDB(B1, 0, 1); PG8_SCHED; PG8_LDA(At, 0, 0); PG8_STAGE(PG8_SA(1, 1), a1 + hstep, voffA);
            PG8_WAIT_V(8); PG8_WAIT_L(0); PG8_BAR; PG8_MMA(0, 0, At, B0); PG8_MMA(0, 1, At, B1); PG8_BAR; PG8_SCHED;
            PG8_LDA(At, 0, 1); PG8_STAGE(PG8_SB(0, 0), b2, voffB); PG8_STAGE(PG8_SB(0, 1), b2 + hstep, voffB); PG8_STAGE(PG8_SA(0, 0), a2, voffA);
            PG8_WAIT_V(8); PG8_WAIT_L(0); PG8_BAR; PG8_MMA(1, 0, At, B0); PG8_MMA(1, 1, At, B1); PG8_BAR; PG8_SCHED;
            PG8_LDB(B0, 1, 0); PG8_LDB(B1, 1, 1); PG8_SCHED; PG8_LDA(At, 1, 0); PG8_STAGE(PG8_SA(0, 1), a2 + hstep, voffA);
            PG8_WAIT_V(8); PG8_WAIT_L(0); PG8_BAR; PG8_MMA(0, 0, At, B0); PG8_MMA(0, 1, At, B1); PG8_BAR; PG8_SCHED;
            PG8_LDA(At, 1, 1); PG8_STAGE(PG8_SB(1, 0), b3, voffB); PG8_STAGE(PG8_SB(1, 1), b3 + hstep, voffB); PG8_STAGE(PG8_SA(1, 0), a3, voffA);
            PG8_WAIT_V(8); PG8_WAIT_L(0); PG8_BAR; PG8_MMA(1, 0, At, B0); PG8_MMA(1, 1, At, B1); PG8_BAR; PG8_SCHED;
            } else {
            PG8_LDB(B0, 0, 0); PG8_SCHED; PG8_LDA(At, 0, 0); PG8_STAGE(PG8_SA(1, 1), a1 + hstep, voffA);
            PG8_WAIT_L(8); PG8_BAR; PG8_WAIT_L(0); PG8_MMA(0, 0, At, B0); PG8_BAR; PG8_SCHED;
            PG8_LDB(B1, 0, 1); PG8_STAGE(PG8_SB(0, 0), b2, voffB);
            PG8_BAR; PG8_WAIT_L(0); PG8_MMA(0, 1, At, B1); PG8_BAR;
            PG8_LDA(At, 0, 1); PG8_STAGE(PG8_SA(0, 0), a2, voffA);
            PG8_BAR; PG8_WAIT_L(0); PG8_MMA(1, 0, At, B0); PG8_BAR; PG8_SCHED;
            PG8_STAGE(PG8_SB(0, 1), b2 + hstep, voffB);
            PG8_WAIT_V(6); PG8_BAR; PG8_MMA(1, 1, At, B1); PG8_BAR;
            PG8_LDB(B0, 1, 0); PG8_SCHED; PG8_LDA(At, 1, 0); PG8_STAGE(PG8_SA(0, 1), a2 + hstep, voffA);
            PG8_WAIT_L(8); PG8_BAR; PG8_WAIT_L(0); PG8_MMA(0, 0, At, B0); PG8_BAR; PG8_SCHED;
            PG8_LDB(B1, 1, 1); PG8_STAGE(PG8_SB(1, 0), b3, voffB);
            PG8_BAR; PG8_WAIT_L(0); PG8_MMA(0, 1, At, B1); PG8_BAR;
            PG8_LDA(At, 1, 1); PG8_STAGE(PG8_SA(1, 0), a3, voffA);
            PG8_BAR; PG8_WAIT_L(0); PG8_MMA(1, 0, At, B0); PG8_BAR; PG8_SCHED;
            PG8_STAGE(PG8_SB(1, 1), b3 + hstep, voffB);
            PG8_WAIT_V(6); PG8_BAR; PG8_MMA(1, 1, At, B1); PG8_BAR;
            }
        }
        if constexpr (ALIGN_EPI) { if (wr == 0) PG8_BAR; }
        if constexpr (!Epi::AFTER_DRAIN) { E(acc, cur, wr, wc, fr, fq); S.done(cur); }
        if (!has_next) break;
#pragma unroll
        for (int a = 0; a < 2; ++a)
#pragma unroll
            for (int b = 0; b < 2; ++b)
#pragma unroll
                for (int m = 0; m < 4; ++m)
#pragma unroll
                    for (int n = 0; n < 2; ++n) acc[a][b][m][n] = (f32x4){0.f, 0.f, 0.f, 0.f};
        cur = nxt; cA = nA; cB = nB; ++ui;
        if constexpr (ALIGN_EPI) { if (wr == 1) PG8_BAR; }
    }
    PG8_WAIT_V(0);
    if constexpr (!ALIGN_EPI) { if (wr == 0) PG8_BAR; }
    PG8_BAR;
    if constexpr (Epi::AFTER_DRAIN) { E.fused(acc, cur, wr, wc, fr, fq, lds, wid, lane); S.done(cur); }
#undef PG8_SA
#undef PG8_SB
#undef PG8_STAGE
#undef PG8_LDA
#undef PG8_LDB
#undef PG8_MMA
#undef PG8_WAIT_V
#undef PG8_WAIT_L
#undef PG8_BAR
#undef PG8_SCHED
}
constexpr float SC128 = 0.12751743082459868f;
constexpr float SC64  = 0.18033688011112042f;
constexpr int LDP = 6144, LDH = 5632, LDX = 2048;
typedef float f32x2 __attribute__((ext_vector_type(2)));

__device__ __forceinline__ float rstd_of(const unsigned long long* ssq, int row) {
    return __builtin_amdgcn_rsqf((float)ssq[row] * (9.5367431640625e-07f / 2048.0f) + 1e-6f);
}
__device__ __forceinline__ float rstd_from(unsigned long long s) { return __builtin_amdgcn_rsqf((float)s * (9.5367431640625e-07f / 2048.0f) + 1e-6f); }
struct EpiProj {
    static constexpr bool PERM = true, AFTER_DRAIN = false;
    bf16_t* O; const f32x2* tabD; const f32x2* tabL; const unsigned long long* ssq;
    __device__ __forceinline__ void operator()(const f32x4 (&acc)[2][2][4][2], const Unit& u, int wr, int wc, int fr, int fq) const {
        const int pn = u.pn;
        int kind = 0; float sc = 1.f;
        if (pn < 2) sc = SC128;
        else if (pn >= 6 && pn < 10) { kind = 1; if (pn < 8) sc = SC64; }
        else if (pn >= 12 && pn < 20) { kind = 2; if (pn < 16) sc = SC128; }
        const int row0 = u.pm * BM + wr * 64 + fr;
        const int cl = wc * 32 + 8 * fq;
        const bool ropeD = (kind == 1) && ((wc & 1) == 0) && (fq < 2);
        const bool ropeL = (kind == 2) && (wc == 0);
        const bool rope = ropeD || ropeL;
        const int i0 = 4 * fq;
#pragma unroll
        for (int ai = 0; ai < 2; ++ai) {
            unsigned long long sq[4]; f32x4 cs0[4], cs1[4];
#pragma unroll
            for (int m = 0; m < 4; ++m) { const int row = row0 + ai * HALF + m * 16; sq[m] = ssq[row];
                cs0[m] = (f32x4){1.f, 0.f, 1.f, 0.f}; cs1[m] = (f32x4){1.f, 0.f, 1.f, 0.f};
                if (ropeD) { const f32x4* t = (const f32x4*)(tabD + (size_t)row * 8 + i0); cs0[m] = t[0]; cs1[m] = t[1]; }
                else if (ropeL) { const f32x4* t = (const f32x4*)(tabL + (size_t)row * 16 + i0); cs0[m] = t[0]; cs1[m] = t[1]; } }
            __builtin_amdgcn_sched_barrier(0);
#pragma unroll
            for (int m = 0; m < 4; ++m) {
                const int row = row0 + ai * HALF + m * 16;
                bf16_t* rowp = O + (size_t)row * LDP + pn * BM + cl;
                const float rs = rstd_from(sq[m]);
#pragma unroll
                for (int bj = 0; bj < 2; ++bj) {
                    f32x4 v0 = acc[ai][bj][m][0] * rs, v1 = acc[ai][bj][m][1] * rs;
                    if (rope) {
                        f32x4 w0, w1;
                        w0[0] = v0[0] * cs0[m][0] - v0[1] * cs0[m][1]; w0[1] = v0[1] * cs0[m][0] + v0[0] * cs0[m][1];
                        w0[2] = v0[2] * cs0[m][2] - v0[3] * cs0[m][3]; w0[3] = v0[3] * cs0[m][2] + v0[2] * cs0[m][3];
                        w1[0] = v1[0] * cs1[m][0] - v1[1] * cs1[m][1]; w1[1] = v1[1] * cs1[m][0] + v1[0] * cs1[m][1];
                        w1[2] = v1[2] * cs1[m][2] - v1[3] * cs1[m][3]; w1[3] = v1[3] * cs1[m][2] + v1[2] * cs1[m][3];
                        v0 = w0; v1 = w1;
                    }
                    v0 = v0 * sc; v1 = v1 * sc;
                    u32x4 w; w.x = cvt_pk_bf16(v0[0], v0[1]); w.y = cvt_pk_bf16(v0[2], v0[3]); w.z = cvt_pk_bf16(v1[0], v1[1]); w.w = cvt_pk_bf16(v1[2], v1[3]);
                    *(u32x4*)(rowp + bj * HALF) = w;
                }
            }
        }
    }
};

struct EpiSwiglu {
    static constexpr bool PERM = true, AFTER_DRAIN = false;
    bf16_t* O; const unsigned long long* ssq;
    __device__ __forceinline__ float act(float g, float u) const {
        const float e = __builtin_amdgcn_exp2f(-1.4426950408889634f * g);
        return g * u * __builtin_amdgcn_rcpf(1.0f + e);
    }
    __device__ __forceinline__ void operator()(const f32x4 (&acc)[2][2][4][2], const Unit& u, int wr, int wc, int fr, int fq) const {
        const int row0 = u.pm * BM + wr * 64 + fr;
        const int col0 = u.pn * HALF + wc * 32 + 8 * fq;
        unsigned long long sq[2][4];
#pragma unroll
        for (int ai = 0; ai < 2; ++ai)
#pragma unroll
            for (int m = 0; m < 4; ++m) sq[ai][m] = ssq[row0 + ai * HALF + m * 16];
        __builtin_amdgcn_sched_barrier(0);
#pragma unroll
        for (int ai = 0; ai < 2; ++ai)
#pragma unroll
            for (int m = 0; m < 4; ++m) {
                bf16_t* rowp = O + (size_t)(row0 + ai * HALF + m * 16) * LDH + col0;
                const float rs = rstd_from(sq[ai][m]);
                const f32x4 g0 = acc[ai][0][m][0] * rs, g1 = acc[ai][0][m][1] * rs, u0 = acc[ai][1][m][0] * rs, u1 = acc[ai][1][m][1] * rs;
                u32x4 w;
                w.x = cvt_pk_bf16(act(g0[0], u0[0]), act(g0[1], u0[1])); w.y = cvt_pk_bf16(act(g0[2], u0[2]), act(g0[3], u0[3]));
                w.z = cvt_pk_bf16(act(g1[0], u1[0]), act(g1[1], u1[1])); w.w = cvt_pk_bf16(act(g1[2], u1[2]), act(g1[3], u1[3]));
                *(u32x4*)rowp = w;
            }
    }
};

struct EpiResid {
    static constexpr bool PERM = true, AFTER_DRAIN = false;
    const float* base; float* out;
    __device__ __forceinline__ void operator()(const f32x4 (&acc)[2][2][4][2], const Unit& u, int wr, int wc, int fr, int fq) const {
        const int row0 = u.pm * BM + wr * 64 + fr;
        const int col0 = u.pn * BM + wc * 32 + 8 * fq;
#pragma unroll
        for (int ai = 0; ai < 2; ++ai)
#pragma unroll
            for (int m = 0; m < 4; ++m) {
                const size_t off = (size_t)(row0 + ai * HALF + m * 16) * LDX + col0;
#pragma unroll
                for (int bj = 0; bj < 2; ++bj)
#pragma unroll
                    for (int n = 0; n < 2; ++n) {
                        const f32x4 b = *(const f32x4*)(base + off + bj * HALF + n * 4);
                        *(f32x4*)(out + off + bj * HALF + n * 4) = b + acc[ai][bj][m][n];
                    }
            }
    }
};
struct EpiResidNorm {
    static constexpr bool PERM = true, AFTER_DRAIN = false;
    const float* base; float* out; bf16_t* xb; unsigned long long* ssq;
    __device__ __forceinline__ void operator()(const f32x4 (&acc)[2][2][4][2], const Unit& u, int wr, int wc, int fr, int fq) const {
        const int row0 = u.pm * BM + wr * 64 + fr;
        const int col0 = u.pn * BM + wc * 32 + 8 * fq;
#pragma unroll
        for (int ai = 0; ai < 2; ++ai)
#pragma unroll
            for (int m = 0; m < 4; ++m) {
                const int row = row0 + ai * HALF + m * 16;
                const size_t off = (size_t)row * LDX + col0;
                float ss = 0.f;
#pragma unroll
                for (int bj = 0; bj < 2; ++bj)
#pragma unroll
                    for (int n = 0; n < 2; ++n) {
                        const f32x4 b = *(const f32x4*)(base + off + bj * HALF + n * 4);
                        const f32x4 v = b + acc[ai][bj][m][n];
                        *(f32x4*)(out + off + bj * HALF + n * 4) = v;
                        ss += (v[0] * v[0] + v[1] * v[1]) + (v[2] * v[2] + v[3] * v[3]);
                        unsigned lo = cvt_pk_bf16(v[0], v[1]), hi = cvt_pk_bf16(v[2], v[3]);
                        *(unsigned long long*)(xb + off + bj * HALF + n * 4) = (unsigned long long)lo | ((unsigned long long)hi << 32);
                    }
                ss += __shfl_xor(ss, 16); ss += __shfl_xor(ss, 32);
                if (fq == 0) atomicAdd(ssq + row, (unsigned long long)(ss * 1048576.0f));
            }
    }
};
__device__ __forceinline__ f32x4 bf4_to_f32(unsigned long long w) {
    const unsigned lo = (unsigned)w, hi = (unsigned)(w >> 32);
    return (f32x4){__builtin_bit_cast(float, lo << 16), __builtin_bit_cast(float, lo & 0xffff0000u), __builtin_bit_cast(float, hi << 16), __builtin_bit_cast(float, hi & 0xffff0000u)};
}
struct EpiResidNormB {
    static constexpr bool PERM = true, AFTER_DRAIN = false;
    bf16_t* xb; unsigned long long* ssq;
    __device__ __forceinline__ void operator()(const f32x4 (&acc)[2][2][4][2], const Unit& u, int wr, int wc, int fr, int fq) const {
        const int row0 = u.pm * BM + wr * 64 + fr;
        const int col0 = u.pn * BM + wc * 32 + 8 * fq;
#pragma unroll
        for (int ai = 0; ai < 2; ++ai) {
            u32x4 bw[4][2];
#pragma unroll
            for (int m = 0; m < 4; ++m)
#pragma unroll
                for (int bj = 0; bj < 2; ++bj) bw[m][bj] = *(const u32x4*)(xb + (size_t)(row0 + ai * HALF + m * 16) * LDX + col0 + bj * HALF);
            __builtin_amdgcn_sched_barrier(0);
#pragma unroll
            for (int m = 0; m < 4; ++m) {
                const int row = row0 + ai * HALF + m * 16;
                const size_t off = (size_t)row * LDX + col0;
                float ss = 0.f;
#pragma unroll
                for (int bj = 0; bj < 2; ++bj) {
                    const f32x4 v0 = bf4_to_f32((unsigned long long)bw[m][bj].x | ((unsigned long long)bw[m][bj].y << 32)) + acc[ai][bj][m][0];
                    const f32x4 v1 = bf4_to_f32((unsigned long long)bw[m][bj].z | ((unsigned long long)bw[m][bj].w << 32)) + acc[ai][bj][m][1];
                    ss += (v0[0] * v0[0] + v0[1] * v0[1]) + (v0[2] * v0[2] + v0[3] * v0[3]) + (v1[0] * v1[0] + v1[1] * v1[1]) + (v1[2] * v1[2] + v1[3] * v1[3]);
                    u32x4 w; w.x = cvt_pk_bf16(v0[0], v0[1]); w.y = cvt_pk_bf16(v0[2], v0[3]); w.z = cvt_pk_bf16(v1[0], v1[1]); w.w = cvt_pk_bf16(v1[2], v1[3]);
                    *(u32x4*)(xb + off + bj * HALF) = w;
                }
                ss += __shfl_xor(ss, 16); ss += __shfl_xor(ss, 32);
                if (fq == 0) atomicAdd(ssq + row, (unsigned long long)(ss * 1048576.0f));
            }
        }
    }
};
struct EpiResidB2F {
    static constexpr bool PERM = true, AFTER_DRAIN = false;
    const bf16_t* xb; float* out;
    __device__ __forceinline__ void operator()(const f32x4 (&acc)[2][2][4][2], const Unit& u, int wr, int wc, int fr, int fq) const {
        const int row0 = u.pm * BM + wr * 64 + fr;
        const int col0 = u.pn * BM + wc * 32 + 8 * fq;
#pragma unroll
        for (int ai = 0; ai < 2; ++ai) {
            u32x4 bw[4][2];
#pragma unroll
            for (int m = 0; m < 4; ++m)
#pragma unroll
                for (int bj = 0; bj < 2; ++bj) bw[m][bj] = *(const u32x4*)(xb + (size_t)(row0 + ai * HALF + m * 16) * LDX + col0 + bj * HALF);
            __builtin_amdgcn_sched_barrier(0);
#pragma unroll
            for (int m = 0; m < 4; ++m) {
                const size_t off = (size_t)(row0 + ai * HALF + m * 16) * LDX + col0;
#pragma unroll
                for (int bj = 0; bj < 2; ++bj) {
                    *(f32x4*)(out + off + bj * HALF) = bf4_to_f32((unsigned long long)bw[m][bj].x | ((unsigned long long)bw[m][bj].y << 32)) + acc[ai][bj][m][0];
                    *(f32x4*)(out + off + bj * HALF + 4) = bf4_to_f32((unsigned long long)bw[m][bj].z | ((unsigned long long)bw[m][bj].w << 32)) + acc[ai][bj][m][1];
                }
            }
        }
    }
};
}
#define LAS __attribute__((address_space(3)))
typedef unsigned short bf16_t;
typedef short bf16x8 __attribute__((ext_vector_type(8)));
typedef short v4i16_t __attribute__((ext_vector_type(4)));
typedef float f32x2 __attribute__((ext_vector_type(2)));
typedef float f32x4 __attribute__((ext_vector_type(4)));
typedef float f32x16 __attribute__((ext_vector_type(16)));
typedef unsigned u32x2 __attribute__((ext_vector_type(2)));
typedef unsigned u32x4 __attribute__((ext_vector_type(4)));
typedef __bf16 bf16x2_t __attribute__((ext_vector_type(2)));

constexpr int BATCH = 2, SEQ = 4096, DM = 2048, DEPTH = 2, MROWS = BATCH * SEQ;
constexpr int NPROJ = 6144, DFF = 5632, NGU = 2 * DFF;
constexpr int LDP = NPROJ;
constexpr float NORM_EPS = 1e-6f;
constexpr int NTHREADS = 512, NWAVES = 8;

constexpr size_t MiB = 1u << 20;
constexpr size_t WS_CTL = 0;
constexpr size_t WS_TAB = 1 * MiB;
constexpr size_t WS_WIN = 4 * MiB;
constexpr size_t WS_WOUT = WS_WIN + 48 * MiB;
constexpr size_t WS_WGU = WS_WOUT + 16 * MiB;
constexpr size_t WS_WDN = WS_WGU + 88 * MiB;
constexpr size_t WS_XN = WS_WDN + 44 * MiB;
constexpr size_t WS_PROJ = WS_XN + 32 * MiB;
constexpr size_t WS_MIX = WS_PROJ + 96 * MiB;
constexpr size_t WS_DIFFO = WS_MIX + 32 * MiB;
constexpr size_t WS_ML = WS_DIFFO + 64 * MiB;
constexpr size_t WS_DILP2 = WS_ML + 1 * MiB;
constexpr size_t WS_DLSE = WS_DILP2 + 16 * MiB;
constexpr size_t WS_END = WS_DLSE + 1 * MiB;

constexpr int LDS_RING = 131072, LDS_BYTES = LDS_RING + 256;

__constant__ float INVF[24] = {
    1.000000000e+00f, 1.939227432e-01f, 3.760603070e-02f, 7.292664610e-03f, 1.414213562e-03f, 2.742481884e-04f, 5.318295734e-05f, 1.031338525e-05f,
    1.000000000e+00f, 4.403665960e-01f, 1.939227432e-01f, 8.539710194e-02f, 3.760603070e-02f, 1.656044088e-02f, 7.292664610e-03f, 3.211446106e-03f,
    1.414213562e-03f, 6.227724371e-04f, 2.742481884e-04f, 1.207697351e-04f, 5.318295734e-05f, 2.341999971e-05f, 1.031338525e-05f, 4.541670478e-06f};


constexpr int Q_NSEG = 18, Q_TOTAL = 1280;
__constant__ int QSEG_START[Q_NSEG] = {0, 32, 48, 80, 96, 128, 160, 176, 208, 240, 256, 288, 320, 336, 352, 480, 1248, 1264};
__constant__ int QSEG_KIND[Q_NSEG]  = {3, 1, 3, 1, 3, 3, 1, 3, 3, 1, 3, 3, 1, 1, 0, 2, 1, 1};
__constant__ int QSEG_QB[Q_NSEG]    = {15, 7, 14, 6, 13, 12, 5, 11, 10, 4, 9, 8, 3, 2, 0, 0, 1, 0};

__device__ __forceinline__ unsigned f2bf(float f) { unsigned u = __builtin_bit_cast(unsigned, f); return (u + 0x7fffu + ((u >> 16) & 1u)) >> 16; }
__device__ __forceinline__ unsigned pk2(float lo, float hi) { return f2bf(lo) | (f2bf(hi) << 16); }
__device__ __forceinline__ unsigned cvtpk(float lo, float hi) { f32x2 v = {lo, hi}; bf16x2_t b = __builtin_convertvector(v, bf16x2_t); return __builtin_bit_cast(unsigned, b); }
__device__ __forceinline__ float wave_sum(float v) {
#pragma unroll
    for (int o = 1; o < 64; o <<= 1) v += __shfl_xor(v, o);
    return v;
}
__device__ __forceinline__ int crow(int r, int hi) { return (r & 3) + 8 * (r >> 2) + 4 * hi; }
#define LDS_WAIT() asm volatile("s_waitcnt lgkmcnt(0)" ::: "memory")
#define CFENCE() asm volatile("" ::: "memory")

__device__ __forceinline__ void sincos_acc(float x, float& s, float& c) {
    const double xd = (double)x;
    const double kd = __builtin_rint(xd * 0.63661977236758134308);
    double r = __builtin_fma(-kd, 1.57079632679489655800e+00, xd);
    r = __builtin_fma(-kd, 6.12323399573676603587e-17, r);
    const long long k = (long long)kd;
    const double r2 = r * r;
    const double sp = r * (1.0 + r2 * (-1.0 / 6.0 + r2 * (1.0 / 120.0 + r2 * (-1.0 / 5040.0 + r2 * (1.0 / 362880.0 + r2 * (-1.0 / 39916800.0 + r2 * (1.0 / 6227020800.0)))))));
    const double cp = 1.0 + r2 * (-0.5 + r2 * (1.0 / 24.0 + r2 * (-1.0 / 720.0 + r2 * (1.0 / 40320.0 + r2 * (-1.0 / 3628800.0 + r2 * (1.0 / 479001600.0 + r2 * (-1.0 / 87178291200.0)))))));
    const int qd = (int)(k & 3);
    const double sv = (qd == 0) ? sp : (qd == 1) ? cp : (qd == 2) ? -sp : -cp;
    const double cv = (qd == 0) ? cp : (qd == 1) ? -sp : (qd == 2) ? -cp : sp;
    s = (float)sv; c = (float)cv;
}

__device__ __forceinline__ void tr_item(const float* __restrict__ W, int K, int N, int sc0, int permkind, bf16_t* __restrict__ WT, int dr0, int k0, LAS float* scr, int lane, const float* __restrict__ gk = nullptr) {
    const int j = lane & 31; int pj = j;
    if (permkind == 1) { if (j < 16) pj = (j >> 1) + 8 * (j & 1); }
    else if (permkind == 2) pj = (j >> 1) + 16 * (j & 1);
    const float* src = W + (size_t)k0 * N + sc0 + pj;
    float tv[32];
#pragma unroll
    for (int i = 0; i < 32; ++i) tv[i] = src[(size_t)(2 * i + (lane >> 5)) * N];
    if (gk) {
#pragma unroll
        for (int i = 0; i < 32; ++i) tv[i] *= gk[k0 + 2 * i + (lane >> 5)];
    }
#pragma unroll
    for (int i = 0; i < 32; ++i) scr[(2 * i + (lane >> 5)) * 33 + j] = tv[i];
    LDS_WAIT();
    const int c = lane & 7;
#pragma unroll
    for (int jj = 0; jj < 4; ++jj) { const int n = (lane >> 3) + 8 * jj; const LAS float* s = scr + (8 * c) * 33 + n;
        u32x4 o; o.x = pk2(s[0 * 33], s[1 * 33]); o.y = pk2(s[2 * 33], s[3 * 33]); o.z = pk2(s[4 * 33], s[5 * 33]); o.w = pk2(s[6 * 33], s[7 * 33]);
        *(u32x4*)(WT + (size_t)(dr0 + n) * K + k0 + 8 * c) = o; }
    LDS_WAIT();
}

struct TrDesc { const float* src; bf16_t* dst; const float* gk; int N, K, k0, pk; bool valid; };
__device__ __forceinline__ void tr_load(const TrDesc& t, int lane, float (&tv)[32]) {
    if (t.pk == 0) {
        const float* src = t.src + (size_t)(lane >> 3) * t.N + 4 * (lane & 7);
#pragma unroll
        for (int i = 0; i < 8; ++i) { const f32x4 v = *(const f32x4*)(src + (size_t)(8 * i) * t.N); tv[4 * i] = v.x; tv[4 * i + 1] = v.y; tv[4 * i + 2] = v.z; tv[4 * i + 3] = v.w; }
        return;
    }
    const int j = lane & 31; int pj = j;
    if (t.pk == 1) { if (j < 16) pj = (j >> 1) + 8 * (j & 1); }
    else if (t.pk == 2) pj = (j >> 1) + 16 * (j & 1);
    const float* src = t.src + pj;
#pragma unroll
    for (int i = 0; i < 32; ++i) tv[i] = src[(size_t)(2 * i + (lane >> 5)) * t.N];
}
__device__ __forceinline__ void tr_finish(const TrDesc& t, float (&tv)[32], LAS float* scr, int lane) {
    if (t.pk == 0) {
        const int r8 = lane >> 3, c4 = lane & 7;
        if (t.gk) {
#pragma unroll
            for (int i = 0; i < 8; ++i) { const float gv = t.gk[t.k0 + 8 * i + r8]; tv[4 * i] *= gv; tv[4 * i + 1] *= gv; tv[4 * i + 2] *= gv; tv[4 * i + 3] *= gv; }
        }
#pragma unroll
        for (int i = 0; i < 8; ++i)
#pragma unroll
            for (int e = 0; e < 4; ++e) scr[(8 * i + r8) * 33 + 4 * c4 + e] = tv[4 * i + e];
    } else {
        const int j = lane & 31;
        if (t.gk) {
#pragma unroll
            for (int i = 0; i < 32; ++i) tv[i] *= t.gk[t.k0 + 2 * i + (lane >> 5)];
        }
#pragma unroll
        for (int i = 0; i < 32; ++i) scr[(2 * i + (lane >> 5)) * 33 + j] = tv[i];
    }
    LDS_WAIT();
    const int c = lane & 7;
#pragma unroll
    for (int jj = 0; jj < 4; ++jj) { const int n = (lane >> 3) + 8 * jj; const LAS float* s = scr + (8 * c) * 33 + n;
        u32x4 o; o.x = pk2(s[0 * 33], s[1 * 33]); o.y = pk2(s[2 * 33], s[3 * 33]); o.z = pk2(s[4 * 33], s[5 * 33]); o.w = pk2(s[6 * 33], s[7 * 33]);
        *(u32x4*)(t.dst + (size_t)n * t.K + 8 * c) = o; }
    LDS_WAIT();
}
__device__ __forceinline__ void xb_rows(const float* src, bf16_t* dst, unsigned long long* ssq, int gw, int ngw, int lane) {
    for (int m = gw; m < MROWS; m += ngw) {
        const f32x4* xr = (const f32x4*)(src + (size_t)m * DM) + lane;
        f32x4 v[8]; float ss = 0.f;
#pragma unroll
        for (int j = 0; j < 8; ++j) { v[j] = xr[64 * j]; ss += (v[j].x * v[j].x + v[j].y * v[j].y) + (v[j].z * v[j].z + v[j].w * v[j].w); }
        ss = wave_sum(ss);
        if (lane == 0) ssq[m] = (unsigned long long)(ss * 1048576.0f);
        u32x2* o8 = (u32x2*)(dst + (size_t)m * DM) + lane;
#pragma unroll
        for (int j = 0; j < 8; ++j) { u32x2 w; w.x = pk2(v[j].x, v[j].y); w.y = pk2(v[j].z, v[j].w); o8[64 * j] = w; }
    }
}
__device__ __forceinline__ void rms_rows_bf16(const float* src, const float* __restrict__ g, bf16_t* dst, int gw, int ngw, int lane) {
    for (int m = gw; m < MROWS; m += ngw) {
        const f32x4* xr = (const f32x4*)(src + (size_t)m * DM) + lane;
        f32x4 v[8]; float ss = 0.f;
#pragma unroll
        for (int j = 0; j < 8; ++j) { v[j] = xr[64 * j]; ss += (v[j].x * v[j].x + v[j].y * v[j].y) + (v[j].z * v[j].z + v[j].w * v[j].w); }
        const float rstd = 1.0f / sqrtf(wave_sum(ss) * (1.0f / DM) + NORM_EPS);
        u32x2* o8 = (u32x2*)(dst + (size_t)m * DM) + lane;
#pragma unroll
        for (int j = 0; j < 8; ++j) { const f32x4 gv = ((const f32x4*)g)[lane + 64 * j]; const f32x4 y = v[j] * rstd * gv;
            u32x2 w; w.x = pk2(y.x, y.y); w.y = pk2(y.z, y.w); o8[64 * j] = w; }
    }
}
__device__ __forceinline__ void rms_rows_f32_inplace(float* buf, const float* __restrict__ g, int gw, int ngw, int lane) {
    for (int m = gw; m < MROWS; m += ngw) {
        f32x4* xr = (f32x4*)(buf + (size_t)m * DM) + lane;
        f32x4 v[8]; float ss = 0.f;
#pragma unroll
        for (int j = 0; j < 8; ++j) { v[j] = xr[64 * j]; ss += (v[j].x * v[j].x + v[j].y * v[j].y) + (v[j].z * v[j].z + v[j].w * v[j].w); }
        const float rstd = 1.0f / sqrtf(wave_sum(ss) * (1.0f / DM) + NORM_EPS);
#pragma unroll
        for (int j = 0; j < 8; ++j) { const f32x4 gv = ((const f32x4*)g)[lane + 64 * j]; xr[64 * j] = v[j] * rstd * gv; }
    }
}

constexpr int VRS = 320;
#define SCHED_FENCE() __builtin_amdgcn_sched_barrier(0)
__device__ __forceinline__ float xhalf_max(float x) { auto rr = __builtin_amdgcn_permlane32_swap(__float_as_uint(x), __float_as_uint(x), false, false); return fmaxf(__uint_as_float(rr[0]), __uint_as_float(rr[1])); }
__device__ __forceinline__ float xhalf_sum(float x) { auto rr = __builtin_amdgcn_permlane32_swap(__float_as_uint(x), __float_as_uint(x), false, false); return __uint_as_float(rr[0]) + __uint_as_float(rr[1]); }
template <int NDS>
__device__ __forceinline__ f32x16 qk_lds(LAS const unsigned char* kl  , const bf16x8 (&qf)[NDS]) {
    bf16x8 kf[NDS];
#pragma unroll
    for (int ds = 0; ds < NDS; ++ds) kf[ds] = *(LAS const bf16x8*)(kl + 32 * ds);
    SCHED_FENCE();
    f32x16 s = {};
    __builtin_amdgcn_s_setprio(1);
#pragma unroll
    for (int ds = 0; ds < NDS; ++ds) s = __builtin_amdgcn_mfma_f32_32x32x16_bf16(kf[ds], qf[ds], s, 0, 0, 0);
    __builtin_amdgcn_s_setprio(0);
    return s;
}
__device__ __forceinline__ bf16x8 pack8(const f32x16& p, int b) {
    u32x4 w; w.x = cvtpk(p[b + 0], p[b + 1]); w.y = cvtpk(p[b + 2], p[b + 3]); w.z = cvtpk(p[b + 4], p[b + 5]); w.w = cvtpk(p[b + 6], p[b + 7]);
    return __builtin_bit_cast(bf16x8, w);
}
__device__ __forceinline__ v4i16_t vtr(LAS const unsigned char* p) { return __builtin_amdgcn_ds_read_tr16_b64_v4i16((LAS v4i16_t*)p); }
struct VFrag { v4i16_t a0, a1, b0, b1; };
__device__ __forceinline__ VFrag vfrag_read(LAS const unsigned char* vlane, int db) {
    VFrag f; f.a0 = vtr(vlane + db * 64); f.a1 = vtr(vlane + db * 64 + 8 * VRS); f.b0 = vtr(vlane + db * 64 + 16 * VRS); f.b1 = vtr(vlane + db * 64 + 24 * VRS); return f;
}
__device__ __forceinline__ void pv_accum(f32x16 (&o)[4], LAS const unsigned char* vlane, const f32x16& p, VFrag f) {
    const bf16x8 pb0 = pack8(p, 0), pb1 = pack8(p, 8);
    __builtin_amdgcn_s_setprio(1);
#pragma unroll
    for (int db = 0; db < 4; ++db) {
        VFrag n = f;
        if (db < 3) n = vfrag_read(vlane, db + 1);
        SCHED_FENCE();
        const bf16x8 v0 = (bf16x8){f.a0[0], f.a0[1], f.a0[2], f.a0[3], f.a1[0], f.a1[1], f.a1[2], f.a1[3]};
        const bf16x8 v1 = (bf16x8){f.b0[0], f.b0[1], f.b0[2], f.b0[3], f.b1[0], f.b1[1], f.b1[2], f.b1[3]};
        o[db] = __builtin_amdgcn_mfma_f32_32x32x16_bf16(v0, pb0, o[db], 0, 0, 0);
        o[db] = __builtin_amdgcn_mfma_f32_32x32x16_bf16(v1, pb1, o[db], 0, 0, 0);
        SCHED_FENCE();
        f = n;
    }
    __builtin_amdgcn_s_setprio(0);
}
constexpr float SM_THR = 8.0f;
__device__ __forceinline__ void softmax_step(f32x16& s, float& m, float& lsum, f32x16 (&o)[4]) {
    float mx = s[0];
#pragma unroll
    for (int r = 1; r < 16; ++r) mx = fmaxf(mx, s[r]);
    mx = xhalf_max(mx);
    if (__any(mx > m + SM_THR)) {
        const float mnew = fmaxf(m, mx); const float alpha = __builtin_amdgcn_exp2f(m - mnew); m = mnew;
        lsum *= alpha;
#pragma unroll
        for (int db = 0; db < 4; ++db) o[db] = o[db] * alpha;
    }
    float ps = 0.f;
#pragma unroll
    for (int r = 0; r < 16; ++r) { s[r] = __builtin_amdgcn_exp2f(s[r] - m); ps += s[r]; }
    lsum += ps;
}
constexpr int OST_RS = 272, OST_WAVE = 32 * OST_RS;
__device__ __forceinline__ void stage_store_bf16(LAS unsigned char* stg, const f32x16 (&o)[4], float sc, const float* __restrict__ g, int lane, bf16_t* dst0, size_t rs) {
    const int q = lane & 31, h = lane >> 5;
#pragma unroll
    for (int db = 0; db < 4; ++db)
#pragma unroll
        for (int a = 0; a < 4; ++a) { const int d0 = 32 * db + 8 * a + 4 * h; f32x4 gv = (f32x4){1.f, 1.f, 1.f, 1.f}; if (g) gv = *(const f32x4*)(g + d0);
            u32x2 w; w.x = cvtpk(o[db][4 * a + 0] * sc * gv.x, o[db][4 * a + 1] * sc * gv.y); w.y = cvtpk(o[db][4 * a + 2] * sc * gv.z, o[db][4 * a + 3] * sc * gv.w);
            *(LAS u32x2*)(stg + q * OST_RS + 2 * d0) = w; }
    CFENCE();
#pragma unroll
    for (int i = 0; i < 8; ++i) { const int row = 4 * i + (lane >> 4), ch = lane & 15;
        const u32x4 v = *(LAS const u32x4*)(stg + row * OST_RS + 16 * ch);
        *(u32x4*)(dst0 + (size_t)row * rs + 8 * ch) = v; }
    CFENCE();
}
__device__ __forceinline__ void stage_store_f32(LAS unsigned char* stg, const f32x16 (&o)[4], int lane, float* dst0, size_t rs) {
    const int q = lane & 31, h = lane >> 5;
#pragma unroll
    for (int hf = 0; hf < 2; ++hf) {
#pragma unroll
        for (int dd = 0; dd < 2; ++dd)
#pragma unroll
            for (int a = 0; a < 4; ++a) { const int d0 = 32 * dd + 8 * a + 4 * h;
                *(LAS f32x4*)(stg + q * OST_RS + 4 * d0) = (f32x4){o[2 * hf + dd][4 * a], o[2 * hf + dd][4 * a + 1], o[2 * hf + dd][4 * a + 2], o[2 * hf + dd][4 * a + 3]}; }
        CFENCE();
#pragma unroll
        for (int i = 0; i < 8; ++i) { const int row = 4 * i + (lane >> 4), ch = lane & 15;
            const f32x4 v = *(LAS const f32x4*)(stg + row * OST_RS + 16 * ch);
            *(f32x4*)(dst0 + (size_t)row * rs + 64 * hf + 4 * ch) = v; }
        CFENCE();
    }
}
__device__ __forceinline__ float head_norm_scale(const f32x16 (&o)[4]) {
    float ss = 0.f;
#pragma unroll
    for (int db = 0; db < 4; ++db)
#pragma unroll
        for (int r = 0; r < 16; ++r) ss += o[db][r] * o[db][r];
    ss = xhalf_sum(ss);
    return 1.0f / sqrtf(ss * (1.0f / 128.0f) + NORM_EPS);
}
__device__ __forceinline__ void head_norm_store(bf16_t* dst, const f32x16 (&o)[4], float pre, const float* __restrict__ g, float mult, int h) {
    float ss = 0.f;
#pragma unroll
    for (int db = 0; db < 4; ++db)
#pragma unroll
        for (int r = 0; r < 16; ++r) { const float v = o[db][r] * pre; ss += v * v; }
    ss += __shfl_xor(ss, 32);
    const float sc = pre * mult / sqrtf(ss * (1.0f / 128.0f) + NORM_EPS);
#pragma unroll
    for (int db = 0; db < 4; ++db)
#pragma unroll
        for (int a = 0; a < 4; ++a) { const int d0 = 32 * db + 8 * a + 4 * h; const f32x4 gv = *(const f32x4*)(g + d0);
            u32x2 w; w.x = cvtpk(o[db][4 * a + 0] * sc * gv.x, o[db][4 * a + 1] * sc * gv.y); w.y = cvtpk(o[db][4 * a + 2] * sc * gv.z, o[db][4 * a + 3] * sc * gv.w);
            *(u32x2*)(dst + d0) = w; }
}

#define LDS_BAR() do { asm volatile("s_waitcnt lgkmcnt(0)" ::: "memory"); __builtin_amdgcn_s_barrier(); asm volatile("" ::: "memory"); } while (0)
struct PFrag { bf16x8 a0, a1, b0, b1; };
template <int NDS, int KRS>
__device__ __forceinline__ void qk_sm64(LAS const unsigned char* kl, const bf16x8 (&qf)[NDS], f32x16 (&o)[4], float& m, float& lsum, PFrag& P) {
    SCHED_FENCE();
    bf16x8 kA[NDS];
#pragma unroll
    for (int ds = 0; ds < NDS; ++ds) kA[ds] = *(LAS const bf16x8*)(kl + 32 * ds);
    SCHED_FENCE();
    f32x16 s0 = {}, s1 = {};
    bf16x8 kB[NDS];
#pragma unroll
    for (int ds = 0; ds < NDS; ++ds) kB[ds] = *(LAS const bf16x8*)(kl + 32 * KRS + 32 * ds);
    __builtin_amdgcn_s_setprio(1);
#pragma unroll
    for (int ds = 0; ds < NDS; ++ds) s0 = __builtin_amdgcn_mfma_f32_32x32x16_bf16(kA[ds], qf[ds], s0, 0, 0, 0);
    SCHED_FENCE();
#pragma unroll
    for (int ds = 0; ds < NDS; ++ds) s1 = __builtin_amdgcn_mfma_f32_32x32x16_bf16(kB[ds], qf[ds], s1, 0, 0, 0);
    __builtin_amdgcn_s_setprio(0);
    float mx = fmaxf(s0[0], s1[0]);
#pragma unroll
    for (int r = 1; r < 16; ++r) mx = fmaxf(fmaxf(mx, s0[r]), s1[r]);
    mx = xhalf_max(mx);
    if (__any(mx > m + SM_THR)) {
        const float mnew = fmaxf(m, mx); const float alpha = __builtin_amdgcn_exp2f(m - mnew); m = mnew;
        lsum *= alpha;
#pragma unroll
        for (int db = 0; db < 4; ++db) o[db] = o[db] * alpha;
    }
    float ps = 0.f;
#pragma unroll
    for (int r = 0; r < 16; ++r) { s0[r] = __builtin_amdgcn_exp2f(s0[r] - m); s1[r] = __builtin_amdgcn_exp2f(s1[r] - m); ps += s0[r] + s1[r]; }
    lsum += ps;
    P.a0 = pack8(s0, 0); P.a1 = pack8(s0, 8); P.b0 = pack8(s1, 0); P.b1 = pack8(s1, 8);
}
template <bool PRE>
__device__ __forceinline__ void pv64(LAS const unsigned char* vl, const PFrag& P, f32x16 (&o)[4]) {
    VFrag f = vfrag_read(vl, 0);
    __builtin_amdgcn_s_setprio(1);
#pragma unroll
    for (int blk = 0; blk < 8; ++blk) {
        const int db = blk >> 1, sub = blk & 1;
        VFrag n = f;
        if (PRE && blk < 7) n = vfrag_read(vl + ((blk + 1) & 1) * 32 * VRS, (blk + 1) >> 1);
        SCHED_FENCE();
        const bf16x8 v0 = (bf16x8){f.a0[0], f.a0[1], f.a0[2], f.a0[3], f.a1[0], f.a1[1], f.a1[2], f.a1[3]};
        const bf16x8 v1 = (bf16x8){f.b0[0], f.b0[1], f.b0[2], f.b0[3], f.b1[0], f.b1[1], f.b1[2], f.b1[3]};
        o[db] = __builtin_amdgcn_mfma_f32_32x32x16_bf16(v0, sub ? P.b0 : P.a0, o[db], 0, 0, 0);
        o[db] = __builtin_amdgcn_mfma_f32_32x32x16_bf16(v1, sub ? P.b1 : P.a1, o[db], 0, 0, 0);
        SCHED_FENCE();
        if (!PRE && blk < 7) n = vfrag_read(vl + ((blk + 1) & 1) * 32 * VRS, (blk + 1) >> 1);
        f = n;
    }
    __builtin_amdgcn_s_setprio(0);
}

template <int MODE, int NDS, int KRS>
__device__ __forceinline__ void cu_tile(LAS const unsigned char* ktile, LAS const unsigned char* vtile, int kv0, int qw0, int qpos, int q, int h, int klane_off, int vlane_off, bool wdone,
                                        const bf16x8 (&qf)[NDS], const bf16x8& T0, const bf16x8& T1, f32x16 (&o)[4], float& m, float& lsum, float& carry) {
#pragma unroll
    for (int sub = 1; sub >= 0; --sub) {
        const int kvs0 = kv0 + 32 * sub;
        if (kvs0 <= qw0 && !wdone && (MODE != 2 || kvs0 >= qw0 - 128)) {
            const bool diag = (kvs0 == qw0);
            LAS const unsigned char* kl = ktile + 32 * sub * KRS + klane_off;
            LAS const unsigned char* vl = vtile + 32 * sub * VRS + vlane_off;
            f32x16 s = qk_lds<NDS>(kl, qf);
            const VFrag vf0 = vfrag_read(vl, 0);
            SCHED_FENCE();
            if (MODE != 0) {
                if (diag) {
#pragma unroll
                    for (int r = 0; r < 16; ++r) if (kvs0 + crow(r, h) > qpos) s[r] = -INFINITY;
                }
                if (MODE == 2 && kvs0 == qw0 - 128) {
#pragma unroll
                    for (int r = 0; r < 16; ++r) if (crow(r, h) < q) s[r] = -INFINITY;
                }
                softmax_step(s, m, lsum, o);
            } else {
                f32x16 sp;
                float tot = 0.f;
#pragma unroll
                for (int r = 0; r < 16; ++r) {
                    const float z = s[r];
                    const float e = __builtin_amdgcn_exp2f(-fabsf(z));
                    float v = fmaxf(z, 0.f) + __builtin_amdgcn_logf(1.0f + e);
                    if (diag && !(kvs0 + crow(r, h) < qpos)) v = 0.f;
                    sp[r] = v; tot += v;
                }
                tot = xhalf_sum(tot);
                const bf16x8 spb0 = pack8(sp, 0), spb1 = pack8(sp, 8);
#pragma unroll
                for (int r = 0; r < 16; ++r) s[r] = s[r] - sp[r] - carry;
                f32x16 w = {};
                w = __builtin_amdgcn_mfma_f32_32x32x16_bf16(T0, spb0, w, 0, 0, 0);
                w = __builtin_amdgcn_mfma_f32_32x32x16_bf16(T1, spb1, w, 0, 0, 0);
#pragma unroll
                for (int r = 0; r < 16; ++r) {
                    float a = __builtin_amdgcn_exp2f(s[r] - w[r]);
                    if (diag && !(kvs0 + crow(r, h) < qpos)) a = 0.f;
                    s[r] = a;
                }
                carry += tot;
            }
            pv_accum(o, vl, s, vf0);
        }
    }
}

template <int MODE>
__device__ __forceinline__ void causal_unit(const bf16_t* __restrict__ P, int b, int qb, int qcol, int kcol, int vcol, LAS unsigned char* lds, int tid, int wid, int lane,
                                            int t_lo, int t_hi, int cls, int stride, volatile LAS unsigned* vote, f32x16 (&o)[4], float& lsum_out, float& m_out) {
    constexpr int DQK = MODE == 1 ? 64 : 128, NDS = DQK / 16, KRS = DQK * 2 + 16, KBUF = 64 * KRS, VBUF = 64 * VRS, CPRK = DQK / 8, NKL = (64 * CPRK) / NTHREADS;
    const int q = lane & 31, h = lane >> 5;
    const size_t rb = (size_t)b * SEQ + cls;
    const int q0 = qb * 256, qw0 = q0 + 32 * wid, qpos = qw0 + q;
    bf16x8 qf[NDS];
#pragma unroll
    for (int ds = 0; ds < NDS; ++ds) qf[ds] = *(const bf16x8*)(P + (rb + (size_t)stride * qpos) * LDP + qcol + 16 * ds + 8 * h);
#pragma unroll
    for (int db = 0; db < 4; ++db) o[db] = (f32x16){};
    float m = -1e30f, lsum = 0.f, carry = 0.f;
    bf16x8 T0, T1;
#pragma unroll
    for (int j = 0; j < 8; ++j) { const int kv = 8 * (j >> 2) + 4 * h + (j & 3); T0[j] = (kv > q) ? (short)0x3F80 : (short)0; T1[j] = (16 + kv > q) ? (short)0x3F80 : (short)0; }
    const int NT = t_hi - t_lo;
    static_assert(NKL == 1 || CPRK == 16, "second K piece = +32 rows");
    const int kgo = stride * (tid / CPRK) * LDP + kcol + 8 * (tid % CPRK), klo = (tid / CPRK) * KRS + 16 * (tid % CPRK);
    const int vgo = stride * (tid >> 4) * LDP + vcol + 8 * (tid & 15), vlo = 3 * KBUF + (tid >> 4) * VRS + 16 * (tid & 15);
#define CU_GLOAD(kr, vr, t) do { const bf16_t* p0_ = P + (rb + (size_t)stride * 64 * (size_t)(t)) * LDP; \
        _Pragma("unroll") for (int i = 0; i < NKL; ++i) kr[i] = *(const u32x4*)(p0_ + kgo + i * 32 * stride * LDP); \
        _Pragma("unroll") for (int i = 0; i < 2; ++i) vr[i] = *(const u32x4*)(p0_ + vgo + i * 32 * stride * LDP); } while (0)
#define CU_LSTORE(kr, vr, buf) do { \
        _Pragma("unroll") for (int i = 0; i < NKL; ++i) *(LAS u32x4*)(lds + (buf) * KBUF + klo + i * 32 * KRS) = kr[i]; \
        _Pragma("unroll") for (int i = 0; i < 2; ++i) *(LAS u32x4*)(lds + (buf) * VBUF + vlo + i * 32 * VRS) = vr[i]; } while (0)
    const int g16 = lane >> 4, i16 = lane & 15;
    const int vlane_off = (4 * h + (i16 >> 2)) * VRS + (16 * (g16 & 1) + 4 * (i16 & 3)) * 2;
    const int klane_off = q * KRS + 16 * h;
    u32x4 krA[NKL], vrA[2], krB[NKL], vrB[2];
    CU_GLOAD(krA, vrA, t_hi - 1); CU_LSTORE(krA, vrA, 0);
    __builtin_amdgcn_s_waitcnt(0x0F70);
#define CU_TCL(t) ((t) < t_lo ? t_lo : (t))
    CU_GLOAD(krA, vrA, CU_TCL(t_hi - 2));
    CU_GLOAD(krB, vrB, CU_TCL(t_hi - 3));
    LDS_BAR();
    bool wdone = false;
#define CU_END_STEP(slot) do { \
        if (MODE == 0) { wdone = __all(carry > 150.0f) != 0; if (lane == 0) vote[(slot) * 8 + wid] = wdone ? 1u : 0u; } \
        LDS_BAR(); \
        if (MODE == 0) { const u32x4 f0 = *(volatile LAS u32x4*)(vote + (slot) * 8), f1 = *(volatile LAS u32x4*)(vote + (slot) * 8 + 4); \
            alldone = (f0.x & f0.y & f0.z & f0.w & f1.x & f1.y & f1.z & f1.w) != 0u; } } while (0)
    bool alldone = false;
    const bool late = (wid >= 4);
    const int n_gen = (MODE == 1) ? ((64 * t_hi > q0) ? 4 : 0) : NT;
    int bi = 0;
#define CU_STEP(WHO, KR, VR, itx, DIST) do { const int bn_ = (bi == 2) ? 0 : bi + 1; \
        LAS const unsigned char* kt_ = lds + bi * KBUF; LAS const unsigned char* vt_ = lds + 3 * KBUF + bi * VBUF; \
        if ((WHO) == 0) cu_tile<MODE, NDS, KRS>(kt_, vt_, 64 * (t_hi - 1 - (itx)), qw0, qpos, q, h, klane_off, vlane_off, wdone, qf, T0, T1, o, m, lsum, carry); \
        else if ((WHO) == 1) { PFrag P_; qk_sm64<NDS, KRS>(kt_ + klane_off, qf, o, m, lsum, P_); pv64<true>(vt_ + vlane_off, P_, o); } \
        else { pv64<false>(vprev, Pp, o); qk_sm64<NDS, KRS>(kt_ + klane_off, qf, o, m, lsum, Pp); vprev = vt_ + vlane_off; } \
        CU_LSTORE(KR, VR, bn_); CU_GLOAD(KR, VR, CU_TCL(t_hi - 1 - (itx) - (DIST))); \
        CU_END_STEP((itx) & 1); bi = bn_; } while (0)
    PFrag Pp; Pp.a0 = (bf16x8){}; Pp.a1 = (bf16x8){}; Pp.b0 = (bf16x8){}; Pp.b1 = (bf16x8){};
    LAS const unsigned char* vprev = lds + 3 * KBUF + vlane_off;
    int it = 0;
    for (; it < n_gen; it += 2) {
        CU_STEP(0, krA, vrA, it, 3);
        if (it + 1 >= NT || alldone) break;
        CU_STEP(0, krB, vrB, it + 1, 3);
        if (alldone) break;
    }
    if (MODE == 1) {
        if (!late) {
            for (; it < NT; it += 2) {
                CU_STEP(1, krA, vrA, it, 2);
                if (it + 1 >= NT) break;
                CU_STEP(1, krA, vrA, it + 1, 2);
            }
        } else {
            for (; it < NT; it += 2) {
                CU_STEP(2, krA, vrA, it, 2);
                if (it + 1 >= NT) break;
                CU_STEP(2, krA, vrA, it + 1, 2);
            }
            pv64<false>(vprev, Pp, o);
        }
        LDS_BAR();
    }
#undef CU_STEP
#undef CU_TCL
#undef CU_END_STEP
#undef CU_GLOAD
#undef CU_LSTORE
    lsum_out = xhalf_sum(lsum); m_out = m;
}

#define XB_TMO      128
#define XB_XCNT(j)  (256  + 64 * (j))
#define XB_XSUB(j)  (1280 + 64 * (j))
#define XB_XGEN(j)  (2304 + 64 * (j))
#define XB_TOP      3328
#define XB_TOPGEN   3392
#define XCD_BAR_WORDS 3456
#define XB_SPIN_CAP (1u << 18)

__device__ __forceinline__ unsigned xb_ld(unsigned* p)              { return __hip_atomic_load(p, __ATOMIC_RELAXED, __HIP_MEMORY_SCOPE_AGENT); }
__device__ __forceinline__ unsigned xb_add(unsigned* p, unsigned v) { return __hip_atomic_fetch_add(p, v, __ATOMIC_RELAXED, __HIP_MEMORY_SCOPE_AGENT); }
__device__ __forceinline__ unsigned xb_xcc_id() { return (unsigned)__builtin_amdgcn_s_getreg((3 << 11) | 20) & 0xFu; }
#define XB_SPIN(cond, bar) do { unsigned _sp = 0; while (cond) { __builtin_amdgcn_s_sleep(1); \
    if ((++_sp & 255u) == 0u) { if (xb_ld(&(bar)[XB_TMO])) break; if (_sp > XB_SPIN_CAP) { atomicAdd(&(bar)[XB_TMO], 1u); break; } } } } while (0)

struct XcdBarrier {
    unsigned* bar; unsigned x;
    volatile LAS unsigned* st;
};

__device__ __forceinline__ XcdBarrier xcd_barrier_post(unsigned* bar, volatile LAS unsigned* st) {
    XcdBarrier b; b.bar = bar; b.x = xb_xcc_id(); b.st = st;
    if (threadIdx.x == 0) (void)xb_add(&bar[XB_XCNT(b.x)], 1u);
    return b;
}
__device__ __forceinline__ void xcd_barrier_complete(unsigned* bar, unsigned x, unsigned& nloc, unsigned& nx) {
    const unsigned G = gridDim.x * gridDim.y * gridDim.z;
    unsigned sum, cnt, mine, sp = 0u;
    for (;;) {
        sum = 0u; cnt = 0u; mine = 0u;
#pragma unroll
        for (unsigned j = 0; j < 16; ++j) { const unsigned c = xb_ld(&bar[XB_XCNT(j)]); sum += c; cnt += (c > 0u) ? 1u : 0u; mine = (j == x) ? c : mine; }
        if (sum == G) break;
        __builtin_amdgcn_s_sleep(1);
        if ((++sp & 255u) == 0u) { if (xb_ld(&bar[XB_TMO])) break; if (sp > XB_SPIN_CAP) { atomicAdd(&bar[XB_TMO], 1u); break; } }
    }
    nloc = mine > 0u ? mine : 1u; nx = cnt > 0u ? cnt : 1u;
}

__device__ __forceinline__ void xcd_barrier(const XcdBarrier& b) {
    asm volatile("s_waitcnt vmcnt(0)" ::: "memory");
    __syncthreads();
    if (threadIdx.x == 0) {
        unsigned* bar = b.bar;
        __builtin_amdgcn_s_waitcnt(0);
        unsigned nloc = b.st[0], nx = b.st[1];
        if (nloc == 0u) { xcd_barrier_complete(bar, b.x, nloc, nx); b.st[0] = nloc; b.st[1] = nx; }
        const unsigned old = xb_add(&bar[XB_XSUB(b.x)], 1u);
        const unsigned gen = old / nloc;
        if (old + 1u == (gen + 1u) * nloc) {
            __builtin_amdgcn_fence(__ATOMIC_RELEASE, "agent");
            asm volatile("s_waitcnt vmcnt(0)" ::: "memory");
            const unsigned og = xb_add(&bar[XB_TOP], 1u);
            const unsigned tg = og / nx;
            if (og + 1u == (tg + 1u) * nx) xb_add(&bar[XB_TOPGEN], 1u);
            else XB_SPIN(xb_ld(&bar[XB_TOPGEN]) == tg, bar);
            __builtin_amdgcn_fence(__ATOMIC_ACQUIRE, "agent");
            xb_add(&bar[XB_XGEN(b.x)], 1u);
            asm volatile("s_waitcnt vmcnt(0)" ::: "memory");
        } else {
            XB_SPIN(xb_ld(&bar[XB_XGEN(b.x)]) == gen, bar);
            __builtin_amdgcn_fence(__ATOMIC_ACQUIRE, "agent");
            asm volatile("s_waitcnt vmcnt(0)" ::: "memory");
        }
    }
    __syncthreads();
}

struct Args {
    const float* x; const int* pos; const float* norm_mix_g; const float* w_in; const float* lq1; const float* lk1; const float* lq2; const float* lk2;
    const float* g_sb; const float* g_diff; const float* g_dil; const float* w_out; const float* norm_ffn_g; const float* w_gate; const float* w_up; const float* w_down;
    const float* norm_final_g; float* out; unsigned char* ws;
};

__global__ void __launch_bounds__(NTHREADS, 2) mega_fwd(Args a) {
    extern __shared__ __attribute__((aligned(16))) unsigned char lds_raw[];
    LAS unsigned char* lds = (LAS unsigned char*)lds_raw;
    volatile LAS unsigned* misc = (volatile LAS unsigned*)(lds + LDS_RING);
    cg::grid_group grid = cg::this_grid();
    if (threadIdx.x < 16) misc[threadIdx.x] = 0u;
    __syncthreads();
    (void)xcd_barrier_post((unsigned*)(a.ws + WS_CTL) + 1024, misc + 8);
#define GRID_SYNC() do { XcdBarrier xb_; xb_.bar = (unsigned*)(a.ws + WS_CTL) + 1024; xb_.x = xb_xcc_id(); xb_.st = misc + 8; xcd_barrier(xb_); } while (0)
#define FRESH_IDS() int tid = threadIdx.x; asm volatile("" : "+v"(tid)); const int lane = tid & 63, wid = __builtin_amdgcn_readfirstlane(tid >> 6); const int gw = blockIdx.x * NWAVES + wid; (void)lane; (void)gw
    const int G = gridDim.x, ngw = G * NWAVES;
#ifdef DIAG
#define STAMP(k) do { if (blockIdx.x == 0 && threadIdx.x == 0) misc[8 + (k)] = (unsigned)__builtin_amdgcn_s_memrealtime(); } while (0)
#else
#define STAMP(k) do {} while (0)
#endif
    STAMP(0);
    unsigned char* ws = a.ws;
    unsigned* ctl = (unsigned*)(ws + WS_CTL);
    pg8::f32x2* tabD = (pg8::f32x2*)(ws + WS_TAB);
    pg8::f32x2* tabL = (pg8::f32x2*)(ws + WS_TAB + 512 * 1024);
    bf16_t* XN = (bf16_t*)(ws + WS_XN); bf16_t* PROJ = (bf16_t*)(ws + WS_PROJ); bf16_t* HB = (bf16_t*)(ws + WS_PROJ); bf16_t* MIX = (bf16_t*)(ws + WS_MIX);
    unsigned long long* SSQ = (unsigned long long*)(ws + WS_CTL + 65536);
    float* DIFFO = (float*)(ws + WS_DIFFO); f32x2* ML = (f32x2*)(ws + WS_ML); float* DLSE = (float*)(ws + WS_DLSE);

#ifdef EXTRA_SYNCS
    for (int i = 0; i < EXTRA_SYNCS; ++i) grid.sync();
#endif
#ifdef EXTRA_BARS
    for (int i = 0; i < EXTRA_BARS; ++i) GRID_SYNC();
#endif
#ifndef PRO_REPS
#define PRO_REPS 1
#endif
    for (int rep = 0; rep < PRO_REPS; ++rep) {
        FRESH_IDS();
        LAS float* scr = (LAS float*)(lds + wid * 16384);
        constexpr int I_IN = 32 * 192, I_OUT = 32 * 64, I_GU = 32 * 352, I_DN = 88 * 64, I_L = I_IN + I_OUT + I_GU + I_DN;
#define PRO_DECODE(T, it_) do { T.valid = false; T.gk = nullptr; T.pk = 0; const int it__ = (it_); if (it__ < DEPTH * I_L) { const int L = it__ / I_L; int r = it__ % I_L; \
            if (r < I_IN) { const int kb = r / 192, nb = r % 192, dr0 = 32 * nb; \
                if (dr0 >= 1536 && dr0 < 2560) T.pk = ((dr0 & 63) == 0) ? 1 : 0; else if (dr0 >= 3072 && dr0 < 5120) T.pk = ((dr0 & 127) == 0) ? 2 : 0; \
                T.N = NPROJ; T.K = DM; T.k0 = 64 * kb; T.src = a.w_in + (size_t)L * DM * NPROJ + (size_t)T.k0 * NPROJ + dr0; \
                T.dst = (bf16_t*)(ws + WS_WIN) + (size_t)L * NPROJ * DM + (size_t)dr0 * DM + T.k0; T.gk = a.norm_mix_g + L * DM; T.valid = true; } \
            else { r -= I_IN; \
                if (!(L == 1 && (r < I_OUT + I_GU / 2 || r >= I_OUT + I_GU))) { \
                    if (r < I_OUT) { const int kb = r / 64, nb = r % 64; T.N = DM; T.K = DM; T.k0 = 64 * kb; \
                        T.src = a.w_out + (size_t)L * DM * DM + (size_t)T.k0 * DM + 32 * nb; T.dst = (bf16_t*)(ws + WS_WOUT) + (size_t)L * DM * DM + (size_t)(32 * nb) * DM + T.k0; T.valid = true; } \
                    else if (r < I_OUT + I_GU) { r -= I_OUT; const int kb = r / 352, nb = r % 352, dr0 = 32 * nb, tile = dr0 >> 8, within = dr0 & 255; \
                        T.N = DFF; T.K = DM; T.k0 = 64 * kb; T.src = ((within >> 7) ? a.w_up : a.w_gate) + (size_t)L * DM * DFF + (size_t)T.k0 * DFF + tile * 128 + (within & 127); \
                        T.dst = (bf16_t*)(ws + WS_WGU) + (size_t)L * NGU * DM + (size_t)dr0 * DM + T.k0; T.gk = a.norm_ffn_g + L * DM; T.valid = true; } \
                    else { r -= I_OUT + I_GU; const int kb = r / 64, nb = r % 64; T.N = DM; T.K = DFF; T.k0 = 64 * kb; \
                        T.src = a.w_down + (size_t)L * DFF * DM + (size_t)T.k0 * DM + 32 * nb; T.dst = (bf16_t*)(ws + WS_WDN) + (size_t)L * DM * DFF + (size_t)(32 * nb) * DFF + T.k0; T.valid = true; } } } } } while (0)
        {
            TrDesc dA, dB; float tvA[32], tvB[32];
            int it = gw;
            PRO_DECODE(dA, it); if (dA.valid) tr_load(dA, lane, tvA);
            while (it < DEPTH * I_L) {
                PRO_DECODE(dB, it + ngw); if (dB.valid) tr_load(dB, lane, tvB);
                if (dA.valid) tr_finish(dA, tvA, scr, lane);
                PRO_DECODE(dA, it + 2 * ngw); if (dA.valid) tr_load(dA, lane, tvA);
                if (dB.valid) tr_finish(dB, tvB, scr, lane);
                it += 2 * ngw;
            }
        }
#undef PRO_DECODE
        for (int idx = blockIdx.x * NTHREADS + tid; idx < MROWS * 24; idx += G * NTHREADS) {
            const int row = idx / 24, i = idx % 24;
            const float ang = (float)a.pos[row] * INVF[i];
            float s, c; sincos_acc(ang, s, c);
            if (i < 8) tabD[(size_t)row * 8 + i] = (pg8::f32x2){c, s}; else tabL[(size_t)row * 16 + (i - 8)] = (pg8::f32x2){c, s};
        }
        xb_rows(a.x, XN, SSQ, gw, ngw, lane);
    }
    if (a.ws == nullptr) grid.sync();
    GRID_SYNC(); STAMP(1);

    for (int L = 0; L < DEPTH; ++L) {
        {
            pg8::Gemm g{XN, (const bf16_t*)(ws + WS_WIN) + (size_t)L * NPROJ * DM, MROWS, NPROJ, DM};
            pg8::StaticOrder S; S.init(MROWS, NPROJ, G, (int)blockIdx.x);
            pg8::EpiProj E{PROJ, tabD, tabL, SSQ + (size_t)(2 * L) * MROWS};
#ifndef G1_REPS
#define G1_REPS 1
#endif
#ifndef G1_ALIGN
#define G1_ALIGN true
#endif
            for (int rep = 0; rep < G1_REPS; ++rep) { if (rep) GRID_SYNC(); pg8::gemm_phase<pg8::EpiProj, pg8::StaticOrder, G1_ALIGN, true>(lds, g, S, E); }
#ifdef G1_ALT
            { GRID_SYNC(); pg8::EpiSwiglu E2{(bf16_t*)DIFFO, SSQ + (size_t)(2 * L) * MROWS}; pg8::gemm_phase<pg8::EpiSwiglu, pg8::StaticOrder, true, true>(lds, g, S, E2); }
#endif
        }
        GRID_SYNC(); STAMP(2 + 8 * L + 0);
#ifndef ATT_REPS
#define ATT_REPS 1
#endif
        for (int rep = 0; rep < ATT_REPS; ++rep) {
            if (rep) GRID_SYNC();
            FRESH_IDS();
            unsigned* ctr = ctl + 64 * (1 + L + 2 * rep);
            for (;;) {
                int tid = threadIdx.x; asm volatile("" : "+v"(tid));
                const int lane = tid & 63;
                __syncthreads();
                if (tid == 0) misc[0] = atomicAdd(ctr, 1u);
                __syncthreads();
                const int idx = (int)misc[0];
                if (idx >= Q_TOTAL) break;
                int seg = 0;
#pragma unroll
                for (int sgi = 1; sgi < Q_NSEG; ++sgi) seg += (idx >= QSEG_START[sgi]) ? 1 : 0;
                const int kind = QSEG_KIND[seg], k = idx - QSEG_START[seg]; int qb = QSEG_QB[seg];
#ifdef ATT_REP_KIND
                if (rep > 0 && (kind & 1 ? 1 : kind) != ATT_REP_KIND) continue;
#endif
                if (kind == 0) {
                    qb = 15 - (k >> 3);
                    const int b = (k >> 2) & 1, head = k & 3;
                    f32x16 o[4]; float ls, mm;
                    causal_unit<0>(PROJ, b, qb, head * 128, 512 + head * 128, 1024 + head * 128, lds, tid, wid, lane, 0, 4 * (qb + 1), 0, 1, misc + 16, o, ls, mm);
                    const int qpos = qb * 256 + 32 * wid + (lane & 31);
                    (void)qpos;
                    stage_store_bf16(lds + wid * OST_WAVE, o, head_norm_scale(o), a.g_sb + L * 128, lane, MIX + ((size_t)b * SEQ + qb * 256 + 32 * wid) * DM + head * 128, DM);
                } else if (kind == 1 || kind == 3) {
                    const int split = (kind == 3) ? (k & 1) : 0, kk = (kind == 3) ? (k >> 1) : k;
                    const int comp = kk & 1, head = (kk >> 1) & 3, b = kk >> 3;
                    const int NTt = 4 * (qb + 1);
                    const int t_lo = (kind == 3 && split == 1) ? NTt / 2 : 0, t_hi = (kind == 3 && split == 0) ? NTt / 2 : NTt;
                    f32x16 o[4]; float ls, mm;
                    causal_unit<1>(PROJ, b, qb, 1536 + head * 128 + comp * 64, 2048 + head * 128 + comp * 64, 2560 + head * 128, lds, tid, wid, lane, t_lo, t_hi, 0, 1, misc + 16, o, ls, mm);
                    const int qpos = qb * 256 + 32 * wid + (lane & 31), h = lane >> 5;
                    const size_t row = (size_t)b * SEQ + qpos;
                    stage_store_bf16(lds + wid * OST_WAVE, o, 1.0f / ls, nullptr, lane, (bf16_t*)DIFFO + (size_t)(comp * 2 + split) * MROWS * 512 + ((size_t)b * SEQ + qb * 256 + 32 * wid) * 512 + head * 128, 512);
                    if (h == 0) ML[((size_t)(comp * 2 + split) * MROWS + row) * 4 + head] = (f32x2){mm, ls};
                } else {
                    const int u16 = k & 15, head = (k >> 4) & 7, b = (k >> 7) & 1, pat = k >> 8;
                    const int stride = pat == 0 ? 16 : (pat == 1 ? 4 : 1);
                    const int cls = u16 % stride, blk = u16 / stride;
                    const int t_hi = 4 * (blk + 1), t_lo = (4 * blk - 2) < 0 ? 0 : (4 * blk - 2);
                    f32x16 o[4]; float ls, mm;
                    causal_unit<2>(PROJ, b, blk, 3072 + head * 128, 4096 + head * 128, 5120 + head * 128, lds, tid, wid, lane, t_lo, t_hi, cls, stride, misc + 16, o, ls, mm);
                    const int qidx = blk * 256 + 32 * wid + (lane & 31), h = lane >> 5;
                    const size_t row = (size_t)b * SEQ + cls + (size_t)stride * qidx;
                    const float inv = 1.0f / ls;
                    bf16_t* dst0 = ((pat == 2) ? (bf16_t*)(ws + WS_DILP2) : (bf16_t*)a.out + (size_t)pat * MROWS * 1024) + ((size_t)b * SEQ + cls + (size_t)stride * (blk * 256 + 32 * wid)) * 1024 + head * 128;
                    stage_store_bf16(lds + wid * OST_WAVE, o, inv, nullptr, lane, dst0, (size_t)stride * 1024);
                    if (h == 0) DLSE[((size_t)pat * MROWS + row) * 8 + head] = mm + __builtin_amdgcn_logf(ls);
                }
            }
        }
        GRID_SYNC(); STAMP(2 + 8 * L + 1);
        {
            FRESH_IDS();
            const float lambda_init = (L == 0) ? 0.2f : 0.35550906759096934f;
            const float s1 = wave_sum(a.lq1[L * 64 + lane] * a.lk1[L * 64 + lane]), s2 = wave_sum(a.lq2[L * 64 + lane] * a.lk2[L * 64 + lane]);
            const float lam = expf(s1) - expf(s2) + lambda_init;
            const int grp = lane >> 4, l16 = lane & 15;
            const f32x4 gd0 = *(const f32x4*)(a.g_diff + L * 128 + 8 * l16), gd1 = *(const f32x4*)(a.g_diff + L * 128 + 8 * l16 + 4);
            for (int it = gw * 4 + grp; it < MROWS * 4; it += ngw * 4) {
                const int row = it >> 2, head = it & 3;
                const bool two = ((row & (SEQ - 1)) >= 2048);
                f32x4 on[2][2];
#pragma unroll
                for (int comp = 0; comp < 2; ++comp) {
                    const size_t i0 = (size_t)(comp * 2) * MROWS + row, i1 = i0 + MROWS;
                    const u32x4 w0 = *(const u32x4*)((const bf16_t*)DIFFO + i0 * 512 + head * 128 + 8 * l16);
                    f32x4 oa = (f32x4){__builtin_bit_cast(float, w0.x << 16), __builtin_bit_cast(float, w0.x & 0xffff0000u), __builtin_bit_cast(float, w0.y << 16), __builtin_bit_cast(float, w0.y & 0xffff0000u)};
                    f32x4 ob = (f32x4){__builtin_bit_cast(float, w0.z << 16), __builtin_bit_cast(float, w0.z & 0xffff0000u), __builtin_bit_cast(float, w0.w << 16), __builtin_bit_cast(float, w0.w & 0xffff0000u)};
                    if (two) {
                        const f32x2 ml0 = ML[i0 * 4 + head], ml1 = ML[i1 * 4 + head];
                        const u32x4 w1 = *(const u32x4*)((const bf16_t*)DIFFO + i1 * 512 + head * 128 + 8 * l16);
                        const f32x4 qa = (f32x4){__builtin_bit_cast(float, w1.x << 16), __builtin_bit_cast(float, w1.x & 0xffff0000u), __builtin_bit_cast(float, w1.y << 16), __builtin_bit_cast(float, w1.y & 0xffff0000u)};
                        const f32x4 qb_ = (f32x4){__builtin_bit_cast(float, w1.z << 16), __builtin_bit_cast(float, w1.z & 0xffff0000u), __builtin_bit_cast(float, w1.w << 16), __builtin_bit_cast(float, w1.w & 0xffff0000u)};
                        const float M = fmaxf(ml0.x, ml1.x); float a0 = ml0.y * __builtin_amdgcn_exp2f(ml0.x - M), a1 = ml1.y * __builtin_amdgcn_exp2f(ml1.x - M);
                        const float ia = 1.0f / (a0 + a1); a0 *= ia; a1 *= ia;
                        oa = oa * a0 + qa * a1; ob = ob * a0 + qb_ * a1;
                    }
                    on[comp][0] = oa; on[comp][1] = ob;
                }
                const f32x4 va = on[0][0] - lam * on[1][0], vb = on[0][1] - lam * on[1][1];
                float ss = (va.x * va.x + va.y * va.y) + (va.z * va.z + va.w * va.w) + (vb.x * vb.x + vb.y * vb.y) + (vb.z * vb.z + vb.w * vb.w);
                ss += __shfl_xor(ss, 1); ss += __shfl_xor(ss, 2); ss += __shfl_xor(ss, 4); ss += __shfl_xor(ss, 8);
                const float sc = (1.0f - lambda_init) / sqrtf(ss * (1.0f / 128.0f) + NORM_EPS);
                u32x4 w; w.x = pk2(va.x * sc * gd0.x, va.y * sc * gd0.y); w.y = pk2(va.z * sc * gd0.z, va.w * sc * gd0.w);
                w.z = pk2(vb.x * sc * gd1.x, vb.y * sc * gd1.y); w.w = pk2(vb.z * sc * gd1.z, vb.w * sc * gd1.w);
                *(u32x4*)(MIX + (size_t)row * DM + 512 + head * 128 + 8 * l16) = w;
            }
            const f32x4 gl0 = *(const f32x4*)(a.g_dil + L * 128 + 8 * l16), gl1 = *(const f32x4*)(a.g_dil + L * 128 + 8 * l16 + 4);
            for (int it = gw * 4 + grp; it < MROWS * 8; it += ngw * 4) {
                const int row = it >> 3, head = it & 7;
                float lse[3]; u32x4 pw[3];
#pragma unroll
                for (int p = 0; p < 3; ++p) { lse[p] = DLSE[((size_t)p * MROWS + row) * 8 + head];
                    const bf16_t* src = (p == 2) ? (const bf16_t*)(ws + WS_DILP2) : (const bf16_t*)a.out + (size_t)p * MROWS * 1024;
                    pw[p] = *(const u32x4*)(src + (size_t)row * 1024 + head * 128 + 8 * l16); }
                const float M = fmaxf(fmaxf(lse[0], lse[1]), lse[2]);
                float w0 = __builtin_amdgcn_exp2f(lse[0] - M), w1 = __builtin_amdgcn_exp2f(lse[1] - M), w2 = __builtin_amdgcn_exp2f(lse[2] - M);
                const float iw = 1.0f / (w0 + w1 + w2); w0 *= iw; w1 *= iw; w2 *= iw;
                float v[8]; float ss = 0.f;
#pragma unroll
                for (int e = 0; e < 4; ++e) {
                    const unsigned u0 = pw[0][e], u1 = pw[1][e], u2 = pw[2][e];
                    v[2 * e] = __builtin_bit_cast(float, u0 << 16) * w0 + __builtin_bit_cast(float, u1 << 16) * w1 + __builtin_bit_cast(float, u2 << 16) * w2;
                    v[2 * e + 1] = __builtin_bit_cast(float, u0 & 0xffff0000u) * w0 + __builtin_bit_cast(float, u1 & 0xffff0000u) * w1 + __builtin_bit_cast(float, u2 & 0xffff0000u) * w2;
                    ss += v[2 * e] * v[2 * e] + v[2 * e + 1] * v[2 * e + 1];
                }
                ss += __shfl_xor(ss, 1); ss += __shfl_xor(ss, 2); ss += __shfl_xor(ss, 4); ss += __shfl_xor(ss, 8);
                const float sc = 1.0f / sqrtf(ss * (1.0f / 128.0f) + NORM_EPS);
                u32x4 w; w.x = pk2(v[0] * sc * gl0.x, v[1] * sc * gl0.y); w.y = pk2(v[2] * sc * gl0.z, v[3] * sc * gl0.w);
                w.z = pk2(v[4] * sc * gl1.x, v[5] * sc * gl1.y); w.w = pk2(v[6] * sc * gl1.z, v[7] * sc * gl1.w);
                *(u32x4*)(MIX + (size_t)row * DM + 1024 + head * 128 + 8 * l16) = w;
            }
        }
        GRID_SYNC(); STAMP(2 + 8 * L + 2);
        {
            pg8::Gemm g{MIX, (const bf16_t*)(ws + WS_WOUT) + (size_t)L * DM * DM, MROWS, DM, DM};
            pg8::StaticOrder S; S.init(MROWS, DM, G, (int)blockIdx.x);
            pg8::EpiResidNormB E{XN, SSQ + (size_t)(2 * L + 1) * MROWS};
            pg8::gemm_phase<pg8::EpiResidNormB, pg8::StaticOrder, true, true>(lds, g, S, E);
#ifdef G2_REPS
            { GRID_SYNC(); pg8::EpiResid E2{a.x, DIFFO}; pg8::gemm_phase<pg8::EpiResid, pg8::StaticOrder, true, true>(lds, g, S, E2); }
#endif
        }
        GRID_SYNC(); STAMP(2 + 8 * L + 3);
        {
            pg8::Gemm g{XN, (const bf16_t*)(ws + WS_WGU) + (size_t)L * NGU * DM, MROWS, NGU, DM};
            pg8::StaticOrder S; S.init(MROWS, NGU, G, (int)blockIdx.x);
            pg8::EpiSwiglu E{HB, SSQ + (size_t)(2 * L + 1) * MROWS};
#ifndef G3_REPS
#define G3_REPS 1
#endif
            for (int rep = 0; rep < G3_REPS; ++rep) { if (rep) GRID_SYNC(); pg8::gemm_phase<pg8::EpiSwiglu, pg8::StaticOrder, true, true>(lds, g, S, E); }
            if (DEPTH > 1 && (int)blockIdx.x * 2 >= G) {
                FRESH_IDS();
                LAS float* scr = (LAS float*)(lds + wid * 16384);
                const int hw = ((int)blockIdx.x - G / 2) * NWAVES + wid, nhw = (G - G / 2) * NWAVES;
                constexpr int J_OUT = 32 * 64, J_GUH = 16 * 352, J_DN = 88 * 64;
                if (L == 0) {
                    for (int r = hw; r < J_OUT + J_GUH; r += nhw) {
                        if (r < J_OUT) { const int kb = r / 64, nb = r % 64;
                            tr_item(a.w_out + (size_t)DM * DM, DM, DM, 32 * nb, 0, (bf16_t*)(ws + WS_WOUT) + (size_t)DM * DM, 32 * nb, 64 * kb, scr, lane); }
                        else { const int r2 = r - J_OUT, kb = r2 / 352, nb = r2 % 352, dr0 = 32 * nb, tile = dr0 >> 8, within = dr0 & 255;
                            const float* src = (within >> 7) ? a.w_up : a.w_gate;
                            tr_item(src + (size_t)DM * DFF, DM, DFF, tile * 128 + (within & 127), 0, (bf16_t*)(ws + WS_WGU) + (size_t)NGU * DM, dr0, 64 * kb, scr, lane, a.norm_ffn_g + DM); }
                    }
                } else if (L == 1) {
                    for (int r = hw; r < J_DN; r += nhw) { const int kb = r / 64, nb = r % 64;
                        tr_item(a.w_down + (size_t)DFF * DM, DFF, DM, 32 * nb, 0, (bf16_t*)(ws + WS_WDN) + (size_t)DM * DFF, 32 * nb, 64 * kb, scr, lane); }
                }
            }
        }
        GRID_SYNC(); STAMP(2 + 8 * L + 5);
        {
            pg8::Gemm g{HB, (const bf16_t*)(ws + WS_WDN) + (size_t)L * DM * DFF, MROWS, DM, DFF};
            pg8::StaticOrder S; S.init(MROWS, DM, G, (int)blockIdx.x);
            if (L + 1 < DEPTH) { pg8::EpiResidNormB E{XN, SSQ + (size_t)(2 * L + 2) * MROWS}; pg8::gemm_phase<pg8::EpiResidNormB, pg8::StaticOrder, true, true>(lds, g, S, E); }
            else { pg8::EpiResidB2F E{XN, a.out}; pg8::gemm_phase<pg8::EpiResidB2F, pg8::StaticOrder, true, true>(lds, g, S, E); }
#ifdef G4_REPS
            { GRID_SYNC(); pg8::EpiResid E2{a.out, DIFFO}; pg8::gemm_phase<pg8::EpiResid, pg8::StaticOrder, true, true>(lds, g, S, E2); }
#endif
        }
        GRID_SYNC(); STAMP(2 + 8 * L + 6);
        if (L + 1 == DEPTH) { FRESH_IDS(); rms_rows_f32_inplace(a.out, a.norm_final_g, gw, ngw, lane); }
    }
#ifdef DIAG
    GRID_SYNC(); STAMP(20);
    if (blockIdx.x == 0) {
        __syncthreads();
        const float t1 = (float)(misc[8 + DIAG_T1B] - misc[8 + DIAG_T1A]) * 0.01f;
        const float t2 = (float)(misc[8 + DIAG_T2B] - misc[8 + DIAG_T2A]) * 0.01f;
        for (int i = threadIdx.x; i < (1 << 20); i += NTHREADS) a.out[i] += t2 * 0.25f;
        if (threadIdx.x == 0) a.out[(size_t)8191 * DM] += t1;
    }
#endif
}

extern "C" void kernel_launch(void* const* d_in, const int* in_sizes, int n_in, void* d_out, int out_size, void* d_ws, size_t ws_size, hipStream_t stream) {
    static int grid = 0;
    if (grid == 0) {
        if (n_in != 17 || out_size != MROWS * DM || ws_size < WS_END) { fprintf(stderr, "kernel_launch: unexpected shapes (n_in %d out %d ws %zu)\n", n_in, out_size, ws_size); grid = -1; return; }
        int dev = 0, cus = 0, per_cu = 0;
        hipGetDevice(&dev); hipDeviceGetAttribute(&cus, hipDeviceAttributeMultiprocessorCount, dev);
        if (hipFuncSetAttribute((const void*)mega_fwd, hipFuncAttributeMaxDynamicSharedMemorySize, LDS_BYTES) != hipSuccess) { fprintf(stderr, "kernel_launch: hipFuncSetAttribute failed\n"); }
        hipOccupancyMaxActiveBlocksPerMultiprocessor(&per_cu, (const void*)mega_fwd, NTHREADS, LDS_BYTES);
        (void)hipGetLastError();
        if (per_cu < 1) { fprintf(stderr, "kernel_launch: occupancy query says %d blocks per CU\n", per_cu); per_cu = 1; }
        grid = cus;
    }
    if (grid < 0) return;
    hipMemsetAsync((char*)d_ws + WS_CTL, 0, 65536 + 4 * MROWS * 8, stream);
    Args a{};
    a.x = (const float*)d_in[0]; a.pos = (const int*)d_in[1]; a.norm_mix_g = (const float*)d_in[2]; a.w_in = (const float*)d_in[3];
    a.lq1 = (const float*)d_in[4]; a.lk1 = (const float*)d_in[5]; a.lq2 = (const float*)d_in[6]; a.lk2 = (const float*)d_in[7];
    a.g_sb = (const float*)d_in[8]; a.g_diff = (const float*)d_in[9]; a.g_dil = (const float*)d_in[10]; a.w_out = (const float*)d_in[11];
    a.norm_ffn_g = (const float*)d_in[12]; a.w_gate = (const float*)d_in[13]; a.w_up = (const float*)d_in[14]; a.w_down = (const float*)d_in[15];
    a.norm_final_g = (const float*)d_in[16]; a.out = (float*)d_out; a.ws = (unsigned char*)d_ws;
    void* args[] = {&a};
    hipError_t e = hipLaunchCooperativeKernel((const void*)mega_fwd, dim3(grid), dim3(NTHREADS), args, LDS_BYTES, stream);
    if (e != hipSuccess) fprintf(stderr, "kernel_launch: cooperative launch failed: %s (grid %d)\n", hipGetErrorString(e), grid);
}
```

```cpp
#include <hip/hip_runtime.h>
#include <hip/hip_cooperative_groups.h>
#include <cstdio>
#include <cstdint>
#include <cmath>
namespace cg = cooperative_groups;
namespace pg8 {
#define PG8_LAS __attribute__((address_space(3)))
typedef unsigned short bf16_t;
typedef short bf16x8 __attribute__((ext_vector_type(8)));
typedef float f32x4 __attribute__((ext_vector_type(4)));
typedef unsigned u32x4 __attribute__((ext_vector_type(4)));
constexpr int BM = 256, BK = 64, HALF = 128, HTB = HALF * BK * 2  , STAGE_BYTES = 8 * HTB, NXCD = 8, WGM = 8;

__host__ __device__ __forceinline__ int lds_byte(int r, int c) { const int st = (r >> 4) * 2 + (c >> 5), rr = r & 15, cc = c & 31, ob = rr * 64 + cc * 2; return st * 1024 + (ob ^ (((ob >> 9) & 1) << 5)); }
__host__ __device__ __forceinline__ void stage_rc(int b, int& R, int& C) { const int st = b / 1024, sb = b % 1024, swz = sb ^ (((sb >> 9) & 1) << 5); R = (st >> 1) * 16 + swz / 64; C = (st & 1) * 32 + (swz % 64) / 2; }
__host__ __device__ __forceinline__ int perm32(int rho) { const int n = rho >> 4, i = rho & 15; return 8 * (i >> 2) + 4 * n + (i & 3); }

struct Unit { int pm, pn; };
struct Gemm { const bf16_t* A; const bf16_t* Bt; int M, N, K; };

struct StaticOrder {
    int nM, nN, nwg, G, c;
    __host__ __device__ void init(int M, int N, int G_, int c_) { nM = M / BM; nN = N / BM; nwg = nM * nN; G = G_; c = c_; }
    __host__ __device__ bool next(int i, Unit& u) const {
        const long L = (long)i * G + c; if (L >= nwg) return false;
        int wgid = (int)L; { const int q = nwg / NXCD, r = nwg % NXCD, xcd = wgid % NXCD, off = wgid / NXCD; wgid = (xcd < r ? xcd * (q + 1) : r * (q + 1) + (xcd - r) * q) + off; }
        const int nig = WGM * nN, gid = wgid / nig, fm = gid * WGM, gsz = (nM - fm) < WGM ? (nM - fm) : WGM;
        u.pm = fm + ((wgid % nig) % gsz); u.pn = (wgid % nig) / gsz; return true;
    }
    __device__ __forceinline__ void a_ready(const Unit&) const {}
    __device__ __forceinline__ void done(const Unit&) const {}
};
__device__ __forceinline__ unsigned cvt_pk_bf16(float lo, float hi) { unsigned r; asm volatile("v_cvt_pk_bf16_f32 %0, %1, %2" : "=v"(r) : "v"(lo), "v"(hi)); return r; }
typedef float f32x2 __attribute__((ext_vector_type(2)));
template <class Epi, class Sched, bool ALIGN_EPI = false, bool SP2 = false>
__device__ __forceinline__ void gemm_phase(PG8_LAS unsigned char* lds, const Gemm g, const Sched& S, const Epi& E) {
    int tid_ = threadIdx.x; asm volatile("" : "+v"(tid_));
    const int tid = tid_, wid = __builtin_amdgcn_readfirstlane(tid >> 6), lane = tid & 63, wr = wid >> 2, wc = wid & 3, fr = lane & 15, fq = lane >> 4;
    const int K = g.K, nt = K / BK;
    unsigned voffA[2], voffB[2];
#pragma unroll
    for (int i = 0; i < 2; ++i) { int R, C; stage_rc(tid * 16 + i * 8192, R, C); const int Rb = Epi::PERM ? ((R & ~31) + perm32(R & 31)) : R;
        voffA[i] = (unsigned)(R * K + C) * 2u; voffB[i] = (unsigned)(Rb * K + C) * 2u; }
    const size_t kstep = (size_t)(BK * 2);
    const size_t hstep = (size_t)HALF * K * 2;
    const size_t tstep = 2 * hstep;
    const unsigned ldsw = (unsigned)wid * 1024u;
    const int aoff = lds_byte(wr * 64 + fr, fq * 8), boff = lds_byte(wc * 32 + fr, fq * 8);
#define PG8_SA(b, h) (((b) * 2 + (h)) * HTB)
#define PG8_SB(b, h) ((4 + (b) * 2 + (h)) * HTB)
#define PG8_STAGE(bufoff, gbase, voff) do { _Pragma("unroll") for (int _i = 0; _i < 2; ++_i) \
        __builtin_amdgcn_global_load_lds((const unsigned*)((const char*)(gbase) + (voff)[_i]), (PG8_LAS unsigned*)(lds + (bufoff) + ldsw + _i * 8192), 16, 0, 0); } while (0)
#define PG8_LDA(dst, b, h) do { _Pragma("unroll") for (int m = 0; m < 4; ++m) _Pragma("unroll") for (int k = 0; k < 2; ++k) dst[m][k] = *(const PG8_LAS bf16x8*)(lds + PG8_SA(b, h) + aoff + m * 2048 + k * 1024); } while (0)
#define PG8_LDB(dst, b, h) do { _Pragma("unroll") for (int n = 0; n < 2; ++n) _Pragma("unroll") for (int k = 0; k < 2; ++k) dst[n][k] = *(const PG8_LAS bf16x8*)(lds + PG8_SB(b, h) + boff + n * 2048 + k * 1024); } while (0)
#define PG8_MMA(ai, bj, At, Bt) do { __builtin_amdgcn_s_setprio(1); _Pragma("unroll") for (int m = 0; m < 4; ++m) _Pragma("unroll") for (int n = 0; n < 2; ++n) _Pragma("unroll") for (int k = 0; k < 2; ++k) \
        acc[ai][bj][m][n] = __builtin_amdgcn_mfma_f32_16x16x32_bf16(Bt[n][k], At[m][k], acc[ai][bj][m][n], 0, 0, 0); __builtin_amdgcn_s_setprio(0); } while (0)
#define PG8_WAIT_V(n) asm volatile("s_waitcnt vmcnt(" #n ")" ::: "memory")
#define PG8_WAIT_L(n) asm volatile("s_waitcnt lgkmcnt(" #n ")" ::: "memory")
#define PG8_BAR __builtin_amdgcn_s_barrier()
#define PG8_SCHED __builtin_amdgcn_sched_barrier(0)
    Unit cur, nxt; int ui = 0;
    if (!S.next(0, cur)) return;
    f32x4 acc[2][2][4][2];
#pragma unroll
    for (int a = 0; a < 2; ++a)
#pragma unroll
        for (int b = 0; b < 2; ++b)
#pragma unroll
            for (int m = 0; m < 4; ++m)
#pragma unroll
                for (int n = 0; n < 2; ++n) acc[a][b][m][n] = (f32x4){0.f, 0.f, 0.f, 0.f};
    bf16x8 At[4][2], B0[2][2], B1[2][2];
    const char* cA = (const char*)g.A + (size_t)cur.pm * tstep; const char* cB = (const char*)g.Bt + (size_t)cur.pn * tstep;
    S.a_ready(cur);
    if constexpr (SP2) {
        PG8_STAGE(PG8_SB(0, 0), cB, voffB); PG8_STAGE(PG8_SB(0, 1), cB + hstep, voffB); PG8_STAGE(PG8_SA(0, 0), cA, voffA); PG8_STAGE(PG8_SA(0, 1), cA + hstep, voffA);
        if (wr == 1) PG8_BAR;
        PG8_WAIT_V(2); PG8_BAR;
        PG8_STAGE(PG8_SB(1, 0), cB + kstep, voffB); PG8_STAGE(PG8_SA(1, 0), cA + kstep, voffA); PG8_STAGE(PG8_SB(1, 1), cB + hstep + kstep, voffB);
        PG8_WAIT_V(6); PG8_BAR;
    } else {
        PG8_STAGE(PG8_SB(0, 0), cB, voffB); PG8_STAGE(PG8_SA(0, 0), cA, voffA); PG8_STAGE(PG8_SB(0, 1), cB + hstep, voffB); PG8_STAGE(PG8_SA(0, 1), cA + hstep, voffA);
        if (wr == 1) PG8_BAR;
        PG8_WAIT_V(4); PG8_BAR;
        PG8_STAGE(PG8_SB(1, 0), cB + kstep, voffB); PG8_STAGE(PG8_SA(1, 0), cA + kstep, voffA); PG8_STAGE(PG8_SB(1, 1), cB + hstep + kstep, voffB);
        PG8_WAIT_V(6); PG8_BAR;
    }
    for (;;) {
        const bool has_next = S.next(ui + 1, nxt);
        const char* nA = has_next ? (const char*)g.A + (size_t)nxt.pm * tstep : cA; const char* nB = has_next ? (const char*)g.Bt + (size_t)nxt.pn * tstep : cB;
        for (int t = 0; t < nt; t += 2) {
            const bool last = (t == nt - 2);
            const char* a1 = cA + (size_t)(t + 1) * kstep;
            const char* a2 = last ? nA : cA + (size_t)(t + 2) * kstep; const char* b2 = last ? nB : cB + (size_t)(t + 2) * kstep;
            const char* a3 = a2 + kstep; const char* b3 = b2 + kstep;
            if (last && has_next) S.a_ready(nxt);
            if constexpr (SP2) {
            PG8_LDB(B0, 0, 0); PG8_LDB(B1, 0, 1); PG8_SCHED; PG8_LDA(At, 0, 0); PG8_STAGE(PG8_SA(1, 1), a1 + hstep, voffA);
            PG8_WAIT_V(8); PG8_WAIT_L(0); PG8_BAR; PG8_MMA(0, 0, At, B0); PG8_MMA(0, 1, At, B1); PG8_BAR; PG8_SCHED;
            PG8_LDA(At, 0, 1); PG8_STAGE(PG8_SB(0, 0), b2, voffB); PG8_STAGE(PG8_SB(0, 1), b2 + hstep, voffB); PG8_STAGE(PG8_SA(0, 0), a2, voffA);
            PG8_WAIT_V(8); PG8_WAIT_L(0); PG8_BAR; PG8_MMA(1, 0, At, B0); PG8_MMA(1, 1, At, B1); PG8_BAR; PG8_SCHED;
            PG8_LDB(B0, 1, 0); PG8_LDB(B1, 1, 1); PG8_SCHED; PG8_LDA(At, 1, 0); PG8_STAGE(PG8_SA(0, 1), a2 + hstep, voffA);
            PG8_WAIT_V(8); PG8_WAIT_L(0); PG8_BAR; PG8_MMA(0, 0, At, B0); PG8_MMA(0, 1, At, B1); PG8_BAR; PG8_SCHED;
            PG8_LDA(At, 1, 1); PG8_STAGE(PG8_SB(1, 0), b3, voffB); PG8_STAGE(PG8_SB(1, 1), b3 + hstep, voffB); PG8_STAGE(PG8_SA(1, 0), a3, voffA);
            PG8_WAIT_V(8); PG8_WAIT_L(0); PG8_BAR; PG8_MMA(1, 0, At, B0); PG8_MMA(1, 1, At, B1); PG8_BAR; PG8_SCHED;
            } else {
            PG8_LDB(B0, 0, 0); PG8_SCHED; PG8_LDA(At, 0, 0); PG8_STAGE(PG8_SA(1, 1), a1 + hstep, voffA);
            PG8_WAIT_L(8); PG8_BAR; PG8_WAIT_L(0); PG8_MMA(0, 0, At, B0); PG8_BAR; PG8_SCHED;
            PG8_LDB(B1, 0, 1); PG8_STAGE(PG8_SB(0, 0), b2, voffB);
            PG8_BAR; PG8_WAIT_L(0); PG8_MMA(0, 1, At, B1); PG8_BAR;
            PG8_LDA(At, 0, 1); PG8_STAGE(PG8_SA(0, 0), a2, voffA);
            PG8_BAR; PG8_WAIT_L(0); PG8_MMA(1, 0, At, B0); PG8_BAR; PG8_SCHED;
            PG8_STAGE(PG8_SB(0, 1), b2 + hstep, voffB);
            PG8_WAIT_V(6); PG8_BAR; PG8_MMA(1, 1, At, B1); PG8_BAR;
            PG8_LDB(B0, 1, 0); PG8_SCHED; PG8_LDA(At, 1, 0); PG8_STAGE(PG8_SA(0, 1), a2 + hstep, voffA);
            PG8_WAIT_L(8); PG8_BAR; PG8_WAIT_L(0); PG8_MMA(0, 0, At, B0); PG8_BAR; PG8_SCHED;
            PG8_LDB(B1, 1, 1); PG8_STAGE(PG8_SB(1, 0), b3, voffB);
            PG8_BAR; PG8_WAIT_L(0); PG8_MMA(0, 1, At, B1); PG8_BAR;
            PG8_LDA(At, 1, 1); PG8_STAGE(PG8_SA(1, 0), a3, voffA);
            PG8_BAR; PG8_WAIT_L(0); PG8_MMA(1, 0, At, B0); PG8_BAR; PG8_SCHED;
            PG8_STAGE(PG8_SB(1, 1), b3 + hstep, voffB);
            PG8_WAIT_V(6); PG8_BAR; PG8_MMA(1, 1, At, B1); PG8_BAR;
            }
        }
        if constexpr (ALIGN_EPI) { if (wr == 0) PG8_BAR; }
        if constexpr (!Epi::AFTER_DRAIN) { E(acc, cur, wr, wc, fr, fq); S.done(cur); }
        if (!has_next) break;
#pragma unroll
        for (int a = 0; a < 2; ++a)
#pragma unroll
            for (int b = 0; b < 2; ++b)
#pragma unroll
                for (int m = 0; m < 4; ++m)
#pragma unroll
                    for (int n = 0; n < 2; ++n) acc[a][b][m][n] = (f32x4){0.f, 0.f, 0.f, 0.f};
        cur = nxt; cA = nA; cB = nB; ++ui;
        if constexpr (ALIGN_EPI) { if (wr == 1) PG8_BAR; }
    }
    PG8_WAIT_V(0);
    if constexpr (!ALIGN_EPI) { if (wr == 0) PG8_BAR; }
    PG8_BAR;
    if constexpr (Epi::AFTER_DRAIN) { E.fused(acc, cur, wr, wc, fr, fq, lds, wid, lane); S.done(cur); }
#undef PG8_SA
#undef PG8_SB
#undef PG8_STAGE
#undef PG8_LDA
#undef PG8_LDB
#undef PG8_MMA
#undef PG8_WAIT_V
#undef PG8_WAIT_L
#undef PG8_BAR
#undef PG8_SCHED
}
constexpr float SC128 = 0.12751743082459868f;
constexpr float SC64  = 0.18033688011112042f;
constexpr int LDP = 6144, LDH = 5632, LDX = 2048;
typedef float f32x2 __attribute__((ext_vector_type(2)));

__device__ __forceinline__ float rstd_of(const unsigned long long* ssq, int row) {
    return __builtin_amdgcn_rsqf((float)ssq[row] * (9.5367431640625e-07f / 2048.0f) + 1e-6f);
}
__device__ __forceinline__ float rstd_from(unsigned long long s) { return __builtin_amdgcn_rsqf((float)s * (9.5367431640625e-07f / 2048.0f) + 1e-6f); }
struct EpiProj {
    static constexpr bool PERM = true, AFTER_DRAIN = false;
    bf16_t* O; const f32x2* tabD; const f32x2* tabL; const unsigned long long* ssq;
    __device__ __forceinline__ void operator()(const f32x4 (&acc)[2][2][4][2], const Unit& u, int wr, int wc, int fr, int fq) const {
        const int pn = u.pn;
        int kind = 0; float sc = 1.f;
        if (pn < 2) sc = SC128;
        else if (pn >= 6 && pn < 10) { kind = 1; if (pn < 8) sc = SC64; }
        else if (pn >= 12 && pn < 20) { kind = 2; if (pn < 16) sc = SC128; }
        const int row0 = u.pm * BM + wr * 64 + fr;
        const int cl = wc * 32 + 8 * fq;
        const bool ropeD = (kind == 1) && ((wc & 1) == 0) && (fq < 2);
        const bool ropeL = (kind == 2) && (wc == 0);
        const bool rope = ropeD || ropeL;
        const int i0 = 4 * fq;
#pragma unroll
        for (int ai = 0; ai < 2; ++ai) {
            unsigned long long sq[4]; f32x4 cs0[4], cs1[4];
#pragma unroll
            for (int m = 0; m < 4; ++m) { const int row = row0 + ai * HALF + m * 16; sq[m] = ssq[row];
                cs0[m] = (f32x4){1.f, 0.f, 1.f, 0.f}; cs1[m] = (f32x4){1.f, 0.f, 1.f, 0.f};
                if (ropeD) { const f32x4* t = (const f32x4*)(tabD + (size_t)row * 8 + i0); cs0[m] = t[0]; cs1[m] = t[1]; }
                else if (ropeL) { const f32x4* t = (const f32x4*)(tabL + (size_t)row * 16 + i0); cs0[m] = t[0]; cs1[m] = t[1]; } }
            __builtin_amdgcn_sched_barrier(0);
#pragma unroll
            for (int m = 0; m < 4; ++m) {
                const int row = row0 + ai * HALF + m * 16;
                bf16_t* rowp = O + (size_t)row * LDP + pn * BM + cl;
                const float rs = rstd_from(sq[m]);
#pragma unroll
                for (int bj = 0; bj < 2; ++bj) {
                    f32x4 v0 = acc[ai][bj][m][0] * rs, v1 = acc[ai][bj][m][1] * rs;
                    if (rope) {
                        f32x4 w0, w1;
                        w0[0] = v0[0] * cs0[m][0] - v0[1] * cs0[m][1]; w0[1] = v0[1] * cs0[m][0] + v0[0] * cs0[m][1];
                        w0[2] = v0[2] * cs0[m][2] - v0[3] * cs0[m][3]; w0[3] = v0[3] * cs0[m][2] + v0[2] * cs0[m][3];
                        w1[0] = v1[0] * cs1[m][0] - v1[1] * cs1[m][1]; w1[1] = v1[1] * cs1[m][0] + v1[0] * cs1[m][1];
                        w1[2] = v1[2] * cs1[m][2] - v1[3] * cs1[m][3]; w1[3] = v1[3] * cs1[m][2] + v1[2] * cs1[m][3];
                        v0 = w0; v1 = w1;
                    }
                    v0 = v0 * sc; v1 = v1 * sc;
                    u32x4 w; w.x = cvt_pk_bf16(v0[0], v0[1]); w.y = cvt_pk_bf16(v0[2], v0[3]); w.z = cvt_pk_bf16(v1[0], v1[1]); w.w = cvt_pk_bf16(v1[2], v1[3]);
                    *(u32x4*)(rowp + bj * HALF) = w;
                }
            }
        }
    }
};

struct EpiSwiglu {
    static constexpr bool PERM = true, AFTER_DRAIN = false;
    bf16_t* O; const unsigned long long* ssq;
    __device__ __forceinline__ float act(float g, float u) const {
        const float e = __builtin_amdgcn_exp2f(-1.4426950408889634f * g);
        return g * u * __builtin_amdgcn_rcpf(1.0f + e);
    }
    __device__ __forceinline__ void operator()(const f32x4 (&acc)[2][2][4][2], const Unit& u, int wr, int wc, int fr, int fq) const {
        const int row0 = u.pm * BM + wr * 64 + fr;
        const int col0 = u.pn * HALF + wc * 32 + 8 * fq;
        unsigned long long sq[2][4];
#pragma unroll
        for (int ai = 0; ai < 2; ++ai)
#pragma unroll
            for (int m = 0; m < 4; ++m) sq[ai][m] = ssq[row0 + ai * HALF + m * 16];
        __builtin_amdgcn_sched_barrier(0);
#pragma unroll
        for (int ai = 0; ai < 2; ++ai)
#pragma unroll
            for (int m = 0; m < 4; ++m) {
                bf16_t* rowp = O + (size_t)(row0 + ai * HALF + m * 16) * LDH + col0;
                const float rs = rstd_from(sq[ai][m]);
                const f32x4 g0 = acc[ai][0][m][0] * rs, g1 = acc[ai][0][m][1] * rs, u0 = acc[ai][1][m][0] * rs, u1 = acc[ai][1][m][1] * rs;
                u32x4 w;
                w.x = cvt_pk_bf16(act(g0[0], u0[0]), act(g0[1], u0[1])); w.y = cvt_pk_bf16(act(g0[2], u0[2]), act(g0[3], u0[3]));
                w.z = cvt_pk_bf16(act(g1[0], u1[0]), act(g1[1], u1[1])); w.w = cvt_pk_bf16(act(g1[2], u1[2]), act(g1[3], u1[3]));
                *(u32x4*)rowp = w;
            }
    }
};

struct EpiResid {
    static constexpr bool PERM = true, AFTER_DRAIN = false;
    const float* base; float* out;
    __device__ __forceinline__ void operator()(const f32x4 (&acc)[2][2][4][2], const Unit& u, int wr, int wc, int fr, int fq) const {
        const int row0 = u.pm * BM + wr * 64 + fr;
        const int col0 = u.pn * BM + wc * 32 + 8 * fq;
#pragma unroll
        for (int ai = 0; ai < 2; ++ai)
#pragma unroll
            for (int m = 0; m < 4; ++m) {
                const size_t off = (size_t)(row0 + ai * HALF + m * 16) * LDX + col0;
#pragma unroll
                for (int bj = 0; bj < 2; ++bj)
#pragma unroll
                    for (int n = 0; n < 2; ++n) {
                        const f32x4 b = *(const f32x4*)(base + off + bj * HALF + n * 4);
                        *(f32x4*)(out + off + bj * HALF + n * 4) = b + acc[ai][bj][m][n];
                    }
            }
    }
};
struct EpiResidNorm {
    static constexpr bool PERM = true, AFTER_DRAIN = false;
    const float* base; float* out; bf16_t* xb; unsigned long long* ssq;
    __device__ __forceinline__ void operator()(const f32x4 (&acc)[2][2][4][2], const Unit& u, int wr, int wc, int fr, int fq) const {
        const int row0 = u.pm * BM + wr * 64 + fr;
        const int col0 = u.pn * BM + wc * 32 + 8 * fq;
#pragma unroll
        for (int ai = 0; ai < 2; ++ai)
#pragma unroll
            for (int m = 0; m < 4; ++m) {
                const int row = row0 + ai * HALF + m * 16;
                const size_t off = (size_t)row * LDX + col0;
                float ss = 0.f;
#pragma unroll
                for (int bj = 0; bj < 2; ++bj)
#pragma unroll
                    for (int n = 0; n < 2; ++n) {
                        const f32x4 b = *(const f32x4*)(base + off + bj * HALF + n * 4);
                        const f32x4 v = b + acc[ai][bj][m][n];
                        *(f32x4*)(out + off + bj * HALF + n * 4) = v;
                        ss += (v[0] * v[0] + v[1] * v[1]) + (v[2] * v[2] + v[3] * v[3]);
                        unsigned lo = cvt_pk_bf16(v[0], v[1]), hi = cvt_pk_bf16(v[2], v[3]);
                        *(unsigned long long*)(xb + off + bj * HALF + n * 4) = (unsigned long long)lo | ((unsigned long long)hi << 32);
                    }
                ss += __shfl_xor(ss, 16); ss += __shfl_xor(ss, 32);
                if (fq == 0) atomicAdd(ssq + row, (unsigned long long)(ss * 1048576.0f));
            }
    }
};
__device__ __forceinline__ f32x4 bf4_to_f32(unsigned long long w) {
    const unsigned lo = (unsigned)w, hi = (unsigned)(w >> 32);
    return (f32x4){__builtin_bit_cast(float, lo << 16), __builtin_bit_cast(float, lo & 0xffff0000u), __builtin_bit_cast(float, hi << 16), __builtin_bit_cast(float, hi & 0xffff0000u)};
}
struct EpiResidNormB {
    static constexpr bool PERM = true, AFTER_DRAIN = false;
    bf16_t* xb; unsigned long long* ssq;
    __device__ __forceinline__ void operator()(const f32x4 (&acc)[2][2][4][2], const Unit& u, int wr, int wc, int fr, int fq) const {
        const int row0 = u.pm * BM + wr * 64 + fr;
        const int col0 = u.pn * BM + wc * 32 + 8 * fq;
#pragma unroll
        for (int ai = 0; ai < 2; ++ai) {
            u32x4 bw[4][2];
#pragma unroll
            for (int m = 0; m < 4; ++m)
#pragma unroll
                for (int bj = 0; bj < 2; ++bj) bw[m][bj] = *(const u32x4*)(xb + (size_t)(row0 + ai * HALF + m * 16) * LDX + col0 + bj * HALF);
            __builtin_amdgcn_sched_barrier(0);
#pragma unroll
            for (int m = 0; m < 4; ++m) {
                const int row = row0 + ai * HALF + m * 16;
                const size_t off = (size_t)row * LDX + col0;
                float ss = 0.f;
#pragma unroll
                for (int bj = 0; bj < 2; ++bj) {
                    const f32x4 v0 = bf4_to_f32((unsigned long long)bw[m][bj].x | ((unsigned long long)bw[m][bj].y << 32)) + acc[ai][bj][m][0];
                    const f32x4 v1 = bf4_to_f32((unsigned long long)bw[m][bj].z | ((unsigned long long)bw[m][bj].w << 32)) + acc[ai][bj][m][1];
                    ss += (v0[0] * v0[0] + v0[1] * v0[1]) + (v0[2] * v0[2] + v0[3] * v0[3]) + (v1[0] * v1[0] + v1[1] * v1[1]) + (v1[2] * v1[2] + v1[3] * v1[3]);
                    u32x4 w; w.x = cvt_pk_bf16(v0[0], v0[1]); w.y = cvt_pk_bf16(v0[2], v0[3]); w.z = cvt_pk_bf16(v1[0], v1[1]); w.w = cvt_pk_bf16(v1[2], v1[3]);
                    *(u32x4*)(xb + off + bj * HALF) = w;
                }
                ss += __shfl_xor(ss, 16); ss += __shfl_xor(ss, 32);
                if (fq == 0) atomicAdd(ssq + row, (unsigned long long)(ss * 1048576.0f));
            }
        }
    }
};
struct EpiResidB2F {
    static constexpr bool PERM = true, AFTER_DRAIN = false;
    const bf16_t* xb; float* out;
    __device__ __forceinline__ void operator()(const f32x4 (&acc)[2][2][4][2], const Unit& u, int wr, int wc, int fr, int fq) const {
        const int row0 = u.pm * BM + wr * 64 + fr;
        const int col0 = u.pn * BM + wc * 32 + 8 * fq;
#pragma unroll
        for (int ai = 0; ai < 2; ++ai) {
            u32x4 bw[4][2];
#pragma unroll
            for (int m = 0; m < 4; ++m)
#pragma unroll
                for (int bj = 0; bj < 2; ++bj) bw[m][bj] = *(const u32x4*)(xb + (size_t)(row0 + ai * HALF + m * 16) * LDX + col0 + bj * HALF);
            __builtin_amdgcn_sched_barrier(0);
#pragma unroll
            for (int m = 0; m < 4; ++m) {
                const size_t off = (size_t)(row0 + ai * HALF + m * 16) * LDX + col0;
#pragma unroll
                for (int bj = 0; bj < 2; ++bj) {
                    *(f32x4*)(out + off + bj * HALF) = bf4_to_f32((unsigned long long)bw[m][bj].x | ((unsigned long long)bw[m][bj].y << 32)) + acc[ai][bj][m][0];
                    *(f32x4*)(out + off + bj * HALF + 4) = bf4_to_f32((unsigned long long)bw[m][bj].z | ((unsigned long long)bw[m][bj].w << 32)) + acc[ai][bj][m][1];
                }
            }
        }
    }
};
}
#define LAS __attribute__((address_space(3)))
typedef unsigned short bf16_t;
typedef short bf16x8 __attribute__((ext_vector_type(8)));
typedef short v4i16_t __attribute__((ext_vector_type(4)));
typedef float f32x2 __attribute__((ext_vector_type(2)));
typedef float f32x4 __attribute__((ext_vector_type(4)));
typedef float f32x16 __attribute__((ext_vector_type(16)));
typedef unsigned u32x2 __attribute__((ext_vector_type(2)));
typedef unsigned u32x4 __attribute__((ext_vector_type(4)));
typedef __bf16 bf16x2_t __attribute__((ext_vector_type(2)));

constexpr int BATCH = 2, SEQ = 4096, DM = 2048, DEPTH = 2, MROWS = BATCH * SEQ;
constexpr int NPROJ = 6144, DFF = 5632, NGU = 2 * DFF;
constexpr int LDP = NPROJ;
constexpr float NORM_EPS = 1e-6f;
constexpr int NTHREADS = 512, NWAVES = 8;

constexpr size_t MiB = 1u << 20;
constexpr size_t WS_CTL = 0;
constexpr size_t WS_TAB = 1 * MiB;
constexpr size_t WS_WIN = 4 * MiB;
constexpr size_t WS_WOUT = WS_WIN + 48 * MiB;
constexpr size_t WS_WGU = WS_WOUT + 16 * MiB;
constexpr size_t WS_WDN = WS_WGU + 88 * MiB;
constexpr size_t WS_XN = WS_WDN + 44 * MiB;
constexpr size_t WS_PROJ = WS_XN + 32 * MiB;
constexpr size_t WS_MIX = WS_PROJ + 96 * MiB;
constexpr size_t WS_DIFFO = WS_MIX + 32 * MiB;
constexpr size_t WS_ML = WS_DIFFO + 64 * MiB;
constexpr size_t WS_DILP2 = WS_ML + 1 * MiB;
constexpr size_t WS_DLSE = WS_DILP2 + 16 * MiB;
constexpr size_t WS_END = WS_DLSE + 1 * MiB;

constexpr int LDS_RING = 131072, LDS_BYTES = LDS_RING + 256;

__constant__ float INVF[24] = {
    1.000000000e+00f, 1.939227432e-01f, 3.760603070e-02f, 7.292664610e-03f, 1.414213562e-03f, 2.742481884e-04f, 5.318295734e-05f, 1.031338525e-05f,
    1.000000000e+00f, 4.403665960e-01f, 1.939227432e-01f, 8.539710194e-02f, 3.760603070e-02f, 1.656044088e-02f, 7.292664610e-03f, 3.211446106e-03f,
    1.414213562e-03f, 6.227724371e-04f, 2.742481884e-04f, 1.207697351e-04f, 5.318295734e-05f, 2.341999971e-05f, 1.031338525e-05f, 4.541670478e-06f};


constexpr int Q_NSEG = 18, Q_TOTAL = 1280;
__constant__ int QSEG_START[Q_NSEG] = {0, 32, 48, 80, 96, 128, 160, 176, 208, 240, 256, 288, 320, 336, 352, 480, 1248, 1264};
__constant__ int QSEG_KIND[Q_NSEG]  = {3, 1, 3, 1, 3, 3, 1, 3, 3, 1, 3, 3, 1, 1, 0, 2, 1, 1};
__constant__ int QSEG_QB[Q_NSEG]    = {15, 7, 14, 6, 13, 12, 5, 11, 10, 4, 9, 8, 3, 2, 0, 0, 1, 0};

__device__ __forceinline__ unsigned f2bf(float f) { unsigned u = __builtin_bit_cast(unsigned, f); return (u + 0x7fffu + ((u >> 16) & 1u)) >> 16; }
__device__ __forceinline__ unsigned pk2(float lo, float hi) { return f2bf(lo) | (f2bf(hi) << 16); }
__device__ __forceinline__ unsigned cvtpk(float lo, float hi) { f32x2 v = {lo, hi}; bf16x2_t b = __builtin_convertvector(v, bf16x2_t); return __builtin_bit_cast(unsigned, b); }
__device__ __forceinline__ float wave_sum(float v) {
#pragma unroll
    for (int o = 1; o < 64; o <<= 1) v += __shfl_xor(v, o);
    return v;
}
__device__ __forceinline__ int crow(int r, int hi) { return (r & 3) + 8 * (r >> 2) + 4 * hi; }
#define LDS_WAIT() asm volatile("s_waitcnt lgkmcnt(0)" ::: "memory")
#define CFENCE() asm volatile("" ::: "memory")

__device__ __forceinline__ void sincos_acc(float x, float& s, float& c) {
    const double xd = (double)x;
    const double kd = __builtin_rint(xd * 0.63661977236758134308);
    double r = __builtin_fma(-kd, 1.57079632679489655800e+00, xd);
    r = __builtin_fma(-kd, 6.12323399573676603587e-17, r);
    const long long k = (long long)kd;
    const double r2 = r * r;
    const double sp = r * (1.0 + r2 * (-1.0 / 6.0 + r2 * (1.0 / 120.0 + r2 * (-1.0 / 5040.0 + r2 * (1.0 / 362880.0 + r2 * (-1.0 / 39916800.0 + r2 * (1.0 / 6227020800.0)))))));
    const double cp = 1.0 + r2 * (-0.5 + r2 * (1.0 / 24.0 + r2 * (-1.0 / 720.0 + r2 * (1.0 / 40320.0 + r2 * (-1.0 / 3628800.0 + r2 * (1.0 / 479001600.0 + r2 * (-1.0 / 87178291200.0)))))));
    const int qd = (int)(k & 3);
    const double sv = (qd == 0) ? sp : (qd == 1) ? cp : (qd == 2) ? -sp : -cp;
    const double cv = (qd == 0) ? cp : (qd == 1) ? -sp : (qd == 2) ? -cp : sp;
    s = (float)sv; c = (float)cv;
}

__device__ __forceinline__ void tr_item(const float* __restrict__ W, int K, int N, int sc0, int permkind, bf16_t* __restrict__ WT, int dr0, int k0, LAS float* scr, int lane, const float* __restrict__ gk = nullptr) {
    const int j = lane & 31; int pj = j;
    if (permkind == 1) { if (j < 16) pj = (j >> 1) + 8 * (j & 1); }
    else if (permkind == 2) pj = (j >> 1) + 16 * (j & 1);
    const float* src = W + (size_t)k0 * N + sc0 + pj;
    float tv[32];
#pragma unroll
    for (int i = 0; i < 32; ++i) tv[i] = src[(size_t)(2 * i + (lane >> 5)) * N];
    if (gk) {
#pragma unroll
        for (int i = 0; i < 32; ++i) tv[i] *= gk[k0 + 2 * i + (lane >> 5)];
    }
#pragma unroll
    for (int i = 0; i < 32; ++i) scr[(2 * i + (lane >> 5)) * 33 + j] = tv[i];
    LDS_WAIT();
    const int c = lane & 7;
#pragma unroll
    for (int jj = 0; jj < 4; ++jj) { const int n = (lane >> 3) + 8 * jj; const LAS float* s = scr + (8 * c) * 33 + n;
        u32x4 o; o.x = pk2(s[0 * 33], s[1 * 33]); o.y = pk2(s[2 * 33], s[3 * 33]); o.z = pk2(s[4 * 33], s[5 * 33]); o.w = pk2(s[6 * 33], s[7 * 33]);
        *(u32x4*)(WT + (size_t)(dr0 + n) * K + k0 + 8 * c) = o; }
    LDS_WAIT();
}

struct TrDesc { const float* src; bf16_t* dst; const float* gk; int N, K, k0, pk; bool valid; };
__device__ __forceinline__ void tr_load(const TrDesc& t, int lane, float (&tv)[32]) {
    const int j = lane & 31; int pj = j;
    if (t.pk == 1) { if (j < 16) pj = (j >> 1) + 8 * (j & 1); }
    else if (t.pk == 2) pj = (j >> 1) + 16 * (j & 1);
    const float* src = t.src + pj;
#pragma unroll
    for (int i = 0; i < 32; ++i) tv[i] = src[(size_t)(2 * i + (lane >> 5)) * t.N];
}
__device__ __forceinline__ void tr_finish(const TrDesc& t, float (&tv)[32], LAS float* scr, int lane) {
    const int j = lane & 31;
    if (t.gk) {
#pragma unroll
        for (int i = 0; i < 32; ++i) tv[i] *= t.gk[t.k0 + 2 * i + (lane >> 5)];
    }
#pragma unroll
    for (int i = 0; i < 32; ++i) scr[(2 * i + (lane >> 5)) * 33 + j] = tv[i];
    LDS_WAIT();
    const int c = lane & 7;
#pragma unroll
    for (int jj = 0; jj < 4; ++jj) { const int n = (lane >> 3) + 8 * jj; const LAS float* s = scr + (8 * c) * 33 + n;
        u32x4 o; o.x = pk2(s[0 * 33], s[1 * 33]); o.y = pk2(s[2 * 33], s[3 * 33]); o.z = pk2(s[4 * 33], s[5 * 33]); o.w = pk2(s[6 * 33], s[7 * 33]);
        *(u32x4*)(t.dst + (size_t)n * t.K + 8 * c) = o; }
    LDS_WAIT();
}
__device__ __forceinline__ void xb_rows(const float* src, bf16_t* dst, unsigned long long* ssq, int gw, int ngw, int lane) {
    for (int m = gw; m < MROWS; m += ngw) {
        const f32x4* xr = (const f32x4*)(src + (size_t)m * DM) + lane;
        f32x4 v[8]; float ss = 0.f;
#pragma unroll
        for (int j = 0; j < 8; ++j) { v[j] = xr[64 * j]; ss += (v[j].x * v[j].x + v[j].y * v[j].y) + (v[j].z * v[j].z + v[j].w * v[j].w); }
        ss = wave_sum(ss);
        if (lane == 0) ssq[m] = (unsigned long long)(ss * 1048576.0f);
        u32x2* o8 = (u32x2*)(dst + (size_t)m * DM) + lane;
#pragma unroll
        for (int j = 0; j < 8; ++j) { u32x2 w; w.x = pk2(v[j].x, v[j].y); w.y = pk2(v[j].z, v[j].w); o8[64 * j] = w; }
    }
}
__device__ __forceinline__ void rms_rows_bf16(const float* src, const float* __restrict__ g, bf16_t* dst, int gw, int ngw, int lane) {
    for (int m = gw; m < MROWS; m += ngw) {
        const f32x4* xr = (const f32x4*)(src + (size_t)m * DM) + lane;
        f32x4 v[8]; float ss = 0.f;
#pragma unroll
        for (int j = 0; j < 8; ++j) { v[j] = xr[64 * j]; ss += (v[j].x * v[j].x + v[j].y * v[j].y) + (v[j].z * v[j].z + v[j].w * v[j].w); }
        const float rstd = 1.0f / sqrtf(wave_sum(ss) * (1.0f / DM) + NORM_EPS);
        u32x2* o8 = (u32x2*)(dst + (size_t)m * DM) + lane;
#pragma unroll
        for (int j = 0; j < 8; ++j) { const f32x4 gv = ((const f32x4*)g)[lane + 64 * j]; const f32x4 y = v[j] * rstd * gv;
            u32x2 w; w.x = pk2(y.x, y.y); w.y = pk2(y.z, y.w); o8[64 * j] = w; }
    }
}
__device__ __forceinline__ void rms_rows_f32_inplace(float* buf, const float* __restrict__ g, int gw, int ngw, int lane) {
    for (int m = gw; m < MROWS; m += ngw) {
        f32x4* xr = (f32x4*)(buf + (size_t)m * DM) + lane;
        f32x4 v[8]; float ss = 0.f;
#pragma unroll
        for (int j = 0; j < 8; ++j) { v[j] = xr[64 * j]; ss += (v[j].x * v[j].x + v[j].y * v[j].y) + (v[j].z * v[j].z + v[j].w * v[j].w); }
        const float rstd = 1.0f / sqrtf(wave_sum(ss) * (1.0f / DM) + NORM_EPS);
#pragma unroll
        for (int j = 0; j < 8; ++j) { const f32x4 gv = ((const f32x4*)g)[lane + 64 * j]; xr[64 * j] = v[j] * rstd * gv; }
    }
}

constexpr int VRS = 320;
#define SCHED_FENCE() __builtin_amdgcn_sched_barrier(0)
__device__ __forceinline__ float xhalf_max(float x) { auto rr = __builtin_amdgcn_permlane32_swap(__float_as_uint(x), __float_as_uint(x), false, false); return fmaxf(__uint_as_float(rr[0]), __uint_as_float(rr[1])); }
__device__ __forceinline__ float xhalf_sum(float x) { auto rr = __builtin_amdgcn_permlane32_swap(__float_as_uint(x), __float_as_uint(x), false, false); return __uint_as_float(rr[0]) + __uint_as_float(rr[1]); }
template <int NDS>
__device__ __forceinline__ f32x16 qk_lds(LAS const unsigned char* kl  , const bf16x8 (&qf)[NDS]) {
    bf16x8 kf[NDS];
#pragma unroll
    for (int ds = 0; ds < NDS; ++ds) kf[ds] = *(LAS const bf16x8*)(kl + 32 * ds);
    SCHED_FENCE();
    f32x16 s = {};
    __builtin_amdgcn_s_setprio(1);
#pragma unroll
    for (int ds = 0; ds < NDS; ++ds) s = __builtin_amdgcn_mfma_f32_32x32x16_bf16(kf[ds], qf[ds], s, 0, 0, 0);
    __builtin_amdgcn_s_setprio(0);
    return s;
}
__device__ __forceinline__ bf16x8 pack8(const f32x16& p, int b) {
    u32x4 w; w.x = cvtpk(p[b + 0], p[b + 1]); w.y = cvtpk(p[b + 2], p[b + 3]); w.z = cvtpk(p[b + 4], p[b + 5]); w.w = cvtpk(p[b + 6], p[b + 7]);
    return __builtin_bit_cast(bf16x8, w);
}
__device__ __forceinline__ v4i16_t vtr(LAS const unsigned char* p) { return __builtin_amdgcn_ds_read_tr16_b64_v4i16((LAS v4i16_t*)p); }
struct VFrag { v4i16_t a0, a1, b0, b1; };
__device__ __forceinline__ VFrag vfrag_read(LAS const unsigned char* vlane, int db) {
    VFrag f; f.a0 = vtr(vlane + db * 64); f.a1 = vtr(vlane + db * 64 + 8 * VRS); f.b0 = vtr(vlane + db * 64 + 16 * VRS); f.b1 = vtr(vlane + db * 64 + 24 * VRS); return f;
}
__device__ __forceinline__ void pv_accum(f32x16 (&o)[4], LAS const unsigned char* vlane, const f32x16& p, VFrag f) {
    const bf16x8 pb0 = pack8(p, 0), pb1 = pack8(p, 8);
    __builtin_amdgcn_s_setprio(1);
#pragma unroll
    for (int db = 0; db < 4; ++db) {
        VFrag n = f;
        if (db < 3) n = vfrag_read(vlane, db + 1);
        SCHED_FENCE();
        const bf16x8 v0 = (bf16x8){f.a0[0], f.a0[1], f.a0[2], f.a0[3], f.a1[0], f.a1[1], f.a1[2], f.a1[3]};
        const bf16x8 v1 = (bf16x8){f.b0[0], f.b0[1], f.b0[2], f.b0[3], f.b1[0], f.b1[1], f.b1[2], f.b1[3]};
        o[db] = __builtin_amdgcn_mfma_f32_32x32x16_bf16(v0, pb0, o[db], 0, 0, 0);
        o[db] = __builtin_amdgcn_mfma_f32_32x32x16_bf16(v1, pb1, o[db], 0, 0, 0);
        SCHED_FENCE();
        f = n;
    }
    __builtin_amdgcn_s_setprio(0);
}
constexpr float SM_THR = 8.0f;
__device__ __forceinline__ void softmax_step(f32x16& s, float& m, float& lsum, f32x16 (&o)[4]) {
    float mx = s[0];
#pragma unroll
    for (int r = 1; r < 16; ++r) mx = fmaxf(mx, s[r]);
    mx = xhalf_max(mx);
    if (__any(mx > m + SM_THR)) {
        const float mnew = fmaxf(m, mx); const float alpha = __builtin_amdgcn_exp2f(m - mnew); m = mnew;
        lsum *= alpha;
#pragma unroll
        for (int db = 0; db < 4; ++db) o[db] = o[db] * alpha;
    }
    float ps = 0.f;
#pragma unroll
    for (int r = 0; r < 16; ++r) { s[r] = __builtin_amdgcn_exp2f(s[r] - m); ps += s[r]; }
    lsum += ps;
}
constexpr int OST_RS = 272, OST_WAVE = 32 * OST_RS;
__device__ __forceinline__ void stage_store_bf16(LAS unsigned char* stg, const f32x16 (&o)[4], float sc, const float* __restrict__ g, int lane, bf16_t* dst0, size_t rs) {
    const int q = lane & 31, h = lane >> 5;
#pragma unroll
    for (int db = 0; db < 4; ++db)
#pragma unroll
        for (int a = 0; a < 4; ++a) { const int d0 = 32 * db + 8 * a + 4 * h; f32x4 gv = (f32x4){1.f, 1.f, 1.f, 1.f}; if (g) gv = *(const f32x4*)(g + d0);
            u32x2 w; w.x = cvtpk(o[db][4 * a + 0] * sc * gv.x, o[db][4 * a + 1] * sc * gv.y); w.y = cvtpk(o[db][4 * a + 2] * sc * gv.z, o[db][4 * a + 3] * sc * gv.w);
            *(LAS u32x2*)(stg + q * OST_RS + 2 * d0) = w; }
    CFENCE();
#pragma unroll
    for (int i = 0; i < 8; ++i) { const int row = 4 * i + (lane >> 4), ch = lane & 15;
        const u32x4 v = *(LAS const u32x4*)(stg + row * OST_RS + 16 * ch);
        *(u32x4*)(dst0 + (size_t)row * rs + 8 * ch) = v; }
    CFENCE();
}
__device__ __forceinline__ void stage_store_f32(LAS unsigned char* stg, const f32x16 (&o)[4], int lane, float* dst0, size_t rs) {
    const int q = lane & 31, h = lane >> 5;
#pragma unroll
    for (int hf = 0; hf < 2; ++hf) {
#pragma unroll
        for (int dd = 0; dd < 2; ++dd)
#pragma unroll
            for (int a = 0; a < 4; ++a) { const int d0 = 32 * dd + 8 * a + 4 * h;
                *(LAS f32x4*)(stg + q * OST_RS + 4 * d0) = (f32x4){o[2 * hf + dd][4 * a], o[2 * hf + dd][4 * a + 1], o[2 * hf + dd][4 * a + 2], o[2 * hf + dd][4 * a + 3]}; }
        CFENCE();
#pragma unroll
        for (int i = 0; i < 8; ++i) { const int row = 4 * i + (lane >> 4), ch = lane & 15;
            const f32x4 v = *(LAS const f32x4*)(stg + row * OST_RS + 16 * ch);
            *(f32x4*)(dst0 + (size_t)row * rs + 64 * hf + 4 * ch) = v; }
        CFENCE();
    }
}
__device__ __forceinline__ float head_norm_scale(const f32x16 (&o)[4]) {
    float ss = 0.f;
#pragma unroll
    for (int db = 0; db < 4; ++db)
#pragma unroll
        for (int r = 0; r < 16; ++r) ss += o[db][r] * o[db][r];
    ss = xhalf_sum(ss);
    return 1.0f / sqrtf(ss * (1.0f / 128.0f) + NORM_EPS);
}
__device__ __forceinline__ void head_norm_store(bf16_t* dst, const f32x16 (&o)[4], float pre, const float* __restrict__ g, float mult, int h) {
    float ss = 0.f;
#pragma unroll
    for (int db = 0; db < 4; ++db)
#pragma unroll
        for (int r = 0; r < 16; ++r) { const float v = o[db][r] * pre; ss += v * v; }
    ss += __shfl_xor(ss, 32);
    const float sc = pre * mult / sqrtf(ss * (1.0f / 128.0f) + NORM_EPS);
#pragma unroll
    for (int db = 0; db < 4; ++db)
#pragma unroll
        for (int a = 0; a < 4; ++a) { const int d0 = 32 * db + 8 * a + 4 * h; const f32x4 gv = *(const f32x4*)(g + d0);
            u32x2 w; w.x = cvtpk(o[db][4 * a + 0] * sc * gv.x, o[db][4 * a + 1] * sc * gv.y); w.y = cvtpk(o[db][4 * a + 2] * sc * gv.z, o[db][4 * a + 3] * sc * gv.w);
            *(u32x2*)(dst + d0) = w; }
}

#define LDS_BAR() do { asm volatile("s_waitcnt lgkmcnt(0)" ::: "memory"); __builtin_amdgcn_s_barrier(); asm volatile("" ::: "memory"); } while (0)
struct PFrag { bf16x8 a0, a1, b0, b1; };
template <int NDS, int KRS>
__device__ __forceinline__ void qk_sm64(LAS const unsigned char* kl, const bf16x8 (&qf)[NDS], f32x16 (&o)[4], float& m, float& lsum, PFrag& P) {
    SCHED_FENCE();
    bf16x8 kA[NDS];
#pragma unroll
    for (int ds = 0; ds < NDS; ++ds) kA[ds] = *(LAS const bf16x8*)(kl + 32 * ds);
    SCHED_FENCE();
    f32x16 s0 = {}, s1 = {};
    bf16x8 kB[NDS];
#pragma unroll
    for (int ds = 0; ds < NDS; ++ds) kB[ds] = *(LAS const bf16x8*)(kl + 32 * KRS + 32 * ds);
    __builtin_amdgcn_s_setprio(1);
#pragma unroll
    for (int ds = 0; ds < NDS; ++ds) s0 = __builtin_amdgcn_mfma_f32_32x32x16_bf16(kA[ds], qf[ds], s0, 0, 0, 0);
    SCHED_FENCE();
#pragma unroll
    for (int ds = 0; ds < NDS; ++ds) s1 = __builtin_amdgcn_mfma_f32_32x32x16_bf16(kB[ds], qf[ds], s1, 0, 0, 0);
    __builtin_amdgcn_s_setprio(0);
    float mx = fmaxf(s0[0], s1[0]);
#pragma unroll
    for (int r = 1; r < 16; ++r) mx = fmaxf(fmaxf(mx, s0[r]), s1[r]);
    mx = xhalf_max(mx);
    if (__any(mx > m + SM_THR)) {
        const float mnew = fmaxf(m, mx); const float alpha = __builtin_amdgcn_exp2f(m - mnew); m = mnew;
        lsum *= alpha;
#pragma unroll
        for (int db = 0; db < 4; ++db) o[db] = o[db] * alpha;
    }
    float ps = 0.f;
#pragma unroll
    for (int r = 0; r < 16; ++r) { s0[r] = __builtin_amdgcn_exp2f(s0[r] - m); s1[r] = __builtin_amdgcn_exp2f(s1[r] - m); ps += s0[r] + s1[r]; }
    lsum += ps;
    P.a0 = pack8(s0, 0); P.a1 = pack8(s0, 8); P.b0 = pack8(s1, 0); P.b1 = pack8(s1, 8);
}
template <bool PRE>
__device__ __forceinline__ void pv64(LAS const unsigned char* vl, const PFrag& P, f32x16 (&o)[4]) {
    VFrag f = vfrag_read(vl, 0);
    __builtin_amdgcn_s_setprio(1);
#pragma unroll
    for (int blk = 0; blk < 8; ++blk) {
        const int db = blk >> 1, sub = blk & 1;
        VFrag n = f;
        if (PRE && blk < 7) n = vfrag_read(vl + ((blk + 1) & 1) * 32 * VRS, (blk + 1) >> 1);
        SCHED_FENCE();
        const bf16x8 v0 = (bf16x8){f.a0[0], f.a0[1], f.a0[2], f.a0[3], f.a1[0], f.a1[1], f.a1[2], f.a1[3]};
        const bf16x8 v1 = (bf16x8){f.b0[0], f.b0[1], f.b0[2], f.b0[3], f.b1[0], f.b1[1], f.b1[2], f.b1[3]};
        o[db] = __builtin_amdgcn_mfma_f32_32x32x16_bf16(v0, sub ? P.b0 : P.a0, o[db], 0, 0, 0);
        o[db] = __builtin_amdgcn_mfma_f32_32x32x16_bf16(v1, sub ? P.b1 : P.a1, o[db], 0, 0, 0);
        SCHED_FENCE();
        if (!PRE && blk < 7) n = vfrag_read(vl + ((blk + 1) & 1) * 32 * VRS, (blk + 1) >> 1);
        f = n;
    }
    __builtin_amdgcn_s_setprio(0);
}

template <int MODE, int NDS, int KRS>
__device__ __forceinline__ void cu_tile(LAS const unsigned char* ktile, LAS const unsigned char* vtile, int kv0, int qw0, int qpos, int q, int h, int klane_off, int vlane_off, bool wdone,
                                        const bf16x8 (&qf)[NDS], const bf16x8& T0, const bf16x8& T1, f32x16 (&o)[4], float& m, float& lsum, float& carry) {
#pragma unroll
    for (int sub = 1; sub >= 0; --sub) {
        const int kvs0 = kv0 + 32 * sub;
        if (kvs0 <= qw0 && !wdone && (MODE != 2 || kvs0 >= qw0 - 128)) {
            const bool diag = (kvs0 == qw0);
            LAS const unsigned char* kl = ktile + 32 * sub * KRS + klane_off;
            LAS const unsigned char* vl = vtile + 32 * sub * VRS + vlane_off;
            f32x16 s = qk_lds<NDS>(kl, qf);
            const VFrag vf0 = vfrag_read(vl, 0);
            SCHED_FENCE();
            if (MODE != 0) {
                if (diag) {
#pragma unroll
                    for (int r = 0; r < 16; ++r) if (kvs0 + crow(r, h) > qpos) s[r] = -INFINITY;
                }
                if (MODE == 2 && kvs0 == qw0 - 128) {
#pragma unroll
                    for (int r = 0; r < 16; ++r) if (crow(r, h) < q) s[r] = -INFINITY;
                }
                softmax_step(s, m, lsum, o);
            } else {
                f32x16 sp;
                float tot = 0.f;
#pragma unroll
                for (int r = 0; r < 16; ++r) {
                    const float z = s[r];
                    const float e = __builtin_amdgcn_exp2f(-fabsf(z));
                    float v = fmaxf(z, 0.f) + __builtin_amdgcn_logf(1.0f + e);
                    if (diag && !(kvs0 + crow(r, h) < qpos)) v = 0.f;
                    sp[r] = v; tot += v;
                }
                tot = xhalf_sum(tot);
                const bf16x8 spb0 = pack8(sp, 0), spb1 = pack8(sp, 8);
#pragma unroll
                for (int r = 0; r < 16; ++r) s[r] = s[r] - sp[r] - carry;
                f32x16 w = {};
                w = __builtin_amdgcn_mfma_f32_32x32x16_bf16(T0, spb0, w, 0, 0, 0);
                w = __builtin_amdgcn_mfma_f32_32x32x16_bf16(T1, spb1, w, 0, 0, 0);
#pragma unroll
                for (int r = 0; r < 16; ++r) {
                    float a = __builtin_amdgcn_exp2f(s[r] - w[r]);
                    if (diag && !(kvs0 + crow(r, h) < qpos)) a = 0.f;
                    s[r] = a;
                }
                carry += tot;
            }
            pv_accum(o, vl, s, vf0);
        }
    }
}

template <int MODE>
__device__ __forceinline__ void causal_unit(const bf16_t* __restrict__ P, int b, int qb, int qcol, int kcol, int vcol, LAS unsigned char* lds, int tid, int wid, int lane,
                                            int t_lo, int t_hi, int cls, int stride, volatile LAS unsigned* vote, f32x16 (&o)[4], float& lsum_out, float& m_out) {
    constexpr int DQK = MODE == 1 ? 64 : 128, NDS = DQK / 16, KRS = DQK * 2 + 16, KBUF = 64 * KRS, VBUF = 64 * VRS, CPRK = DQK / 8, NKL = (64 * CPRK) / NTHREADS;
    const int q = lane & 31, h = lane >> 5;
    const size_t rb = (size_t)b * SEQ + cls;
    const int q0 = qb * 256, qw0 = q0 + 32 * wid, qpos = qw0 + q;
    bf16x8 qf[NDS];
#pragma unroll
    for (int ds = 0; ds < NDS; ++ds) qf[ds] = *(const bf16x8*)(P + (rb + (size_t)stride * qpos) * LDP + qcol + 16 * ds + 8 * h);
#pragma unroll
    for (int db = 0; db < 4; ++db) o[db] = (f32x16){};
    float m = -1e30f, lsum = 0.f, carry = 0.f;
    bf16x8 T0, T1;
#pragma unroll
    for (int j = 0; j < 8; ++j) { const int kv = 8 * (j >> 2) + 4 * h + (j & 3); T0[j] = (kv > q) ? (short)0x3F80 : (short)0; T1[j] = (16 + kv > q) ? (short)0x3F80 : (short)0; }
    const int NT = t_hi - t_lo;
    static_assert(NKL == 1 || CPRK == 16, "second K piece = +32 rows");
    const int kgo = stride * (tid / CPRK) * LDP + kcol + 8 * (tid % CPRK), klo = (tid / CPRK) * KRS + 16 * (tid % CPRK);
    const int vgo = stride * (tid >> 4) * LDP + vcol + 8 * (tid & 15), vlo = 3 * KBUF + (tid >> 4) * VRS + 16 * (tid & 15);
#define CU_GLOAD(kr, vr, t) do { const bf16_t* p0_ = P + (rb + (size_t)stride * 64 * (size_t)(t)) * LDP; \
        _Pragma("unroll") for (int i = 0; i < NKL; ++i) kr[i] = *(const u32x4*)(p0_ + kgo + i * 32 * stride * LDP); \
        _Pragma("unroll") for (int i = 0; i < 2; ++i) vr[i] = *(const u32x4*)(p0_ + vgo + i * 32 * stride * LDP); } while (0)
#define CU_LSTORE(kr, vr, buf) do { \
        _Pragma("unroll") for (int i = 0; i < NKL; ++i) *(LAS u32x4*)(lds + (buf) * KBUF + klo + i * 32 * KRS) = kr[i]; \
        _Pragma("unroll") for (int i = 0; i < 2; ++i) *(LAS u32x4*)(lds + (buf) * VBUF + vlo + i * 32 * VRS) = vr[i]; } while (0)
    const int g16 = lane >> 4, i16 = lane & 15;
    const int vlane_off = (4 * h + (i16 >> 2)) * VRS + (16 * (g16 & 1) + 4 * (i16 & 3)) * 2;
    const int klane_off = q * KRS + 16 * h;
    u32x4 krA[NKL], vrA[2], krB[NKL], vrB[2];
    CU_GLOAD(krA, vrA, t_hi - 1); CU_LSTORE(krA, vrA, 0);
    __builtin_amdgcn_s_waitcnt(0x0F70);
#define CU_TCL(t) ((t) < t_lo ? t_lo : (t))
    CU_GLOAD(krA, vrA, CU_TCL(t_hi - 2));
    CU_GLOAD(krB, vrB, CU_TCL(t_hi - 3));
    LDS_BAR();
    bool wdone = false;
#define CU_END_STEP(slot) do { \
        if (MODE == 0) { wdone = __all(carry > 150.0f) != 0; if (lane == 0) vote[(slot) * 8 + wid] = wdone ? 1u : 0u; } \
        LDS_BAR(); \
        if (MODE == 0) { const u32x4 f0 = *(volatile LAS u32x4*)(vote + (slot) * 8), f1 = *(volatile LAS u32x4*)(vote + (slot) * 8 + 4); \
            alldone = (f0.x & f0.y & f0.z & f0.w & f1.x & f1.y & f1.z & f1.w) != 0u; } } while (0)
    bool alldone = false;
    const bool late = (wid >= 4);
    const int n_gen = (MODE == 1) ? ((64 * t_hi > q0) ? 4 : 0) : NT;
    int bi = 0;
#define CU_STEP(WHO, KR, VR, itx, DIST) do { const int bn_ = (bi == 2) ? 0 : bi + 1; \
        LAS const unsigned char* kt_ = lds + bi * KBUF; LAS const unsigned char* vt_ = lds + 3 * KBUF + bi * VBUF; \
        if ((WHO) == 0) cu_tile<MODE, NDS, KRS>(kt_, vt_, 64 * (t_hi - 1 - (itx)), qw0, qpos, q, h, klane_off, vlane_off, wdone, qf, T0, T1, o, m, lsum, carry); \
        else if ((WHO) == 1) { PFrag P_; qk_sm64<NDS, KRS>(kt_ + klane_off, qf, o, m, lsum, P_); pv64<true>(vt_ + vlane_off, P_, o); } \
        else { pv64<true>(vprev, Pp, o); qk_sm64<NDS, KRS>(kt_ + klane_off, qf, o, m, lsum, Pp); vprev = vt_ + vlane_off; } \
        CU_LSTORE(KR, VR, bn_); CU_GLOAD(KR, VR, CU_TCL(t_hi - 1 - (itx) - (DIST))); \
        CU_END_STEP((itx) & 1); bi = bn_; } while (0)
    PFrag Pp; Pp.a0 = (bf16x8){}; Pp.a1 = (bf16x8){}; Pp.b0 = (bf16x8){}; Pp.b1 = (bf16x8){};
    LAS const unsigned char* vprev = lds + 3 * KBUF + vlane_off;
    int it = 0;
    for (; it < n_gen; it += 2) {
        CU_STEP(0, krA, vrA, it, 3);
        if (it + 1 >= NT || alldone) break;
        CU_STEP(0, krB, vrB, it + 1, 3);
        if (alldone) break;
    }
    if (MODE == 1) {
        if (!late) {
            for (; it < NT; it += 2) {
                CU_STEP(1, krA, vrA, it, 2);
                if (it + 1 >= NT) break;
                CU_STEP(1, krA, vrA, it + 1, 2);
            }
        } else {
            for (; it < NT; it += 2) {
                CU_STEP(2, krA, vrA, it, 2);
                if (it + 1 >= NT) break;
                CU_STEP(2, krA, vrA, it + 1, 2);
            }
            pv64<true>(vprev, Pp, o);
        }
        LDS_BAR();
    }
#undef CU_STEP
#undef CU_TCL
#undef CU_END_STEP
#undef CU_GLOAD
#undef CU_LSTORE
    lsum_out = xhalf_sum(lsum); m_out = m;
}

#define XB_TMO      128
#define XB_XCNT(j)  (256  + 64 * (j))
#define XB_XSUB(j)  (1280 + 64 * (j))
#define XB_XGEN(j)  (2304 + 64 * (j))
#define XB_TOP      3328
#define XB_TOPGEN   3392
#define XCD_BAR_WORDS 3456
#define XB_SPIN_CAP (1u << 18)

__device__ __forceinline__ unsigned xb_ld(unsigned* p)              { return __hip_atomic_load(p, __ATOMIC_RELAXED, __HIP_MEMORY_SCOPE_AGENT); }
__device__ __forceinline__ unsigned xb_add(unsigned* p, unsigned v) { return __hip_atomic_fetch_add(p, v, __ATOMIC_RELAXED, __HIP_MEMORY_SCOPE_AGENT); }
__device__ __forceinline__ unsigned xb_xcc_id() { return (unsigned)__builtin_amdgcn_s_getreg((3 << 11) | 20) & 0xFu; }
#define XB_SPIN(cond, bar) do { unsigned _sp = 0; while (cond) { __builtin_amdgcn_s_sleep(1); \
    if ((++_sp & 255u) == 0u) { if (xb_ld(&(bar)[XB_TMO])) break; if (_sp > XB_SPIN_CAP) { atomicAdd(&(bar)[XB_TMO], 1u); break; } } } } while (0)

struct XcdBarrier {
    unsigned* bar; unsigned x;
    volatile LAS unsigned* st;
};

__device__ __forceinline__ XcdBarrier xcd_barrier_post(unsigned* bar, volatile LAS unsigned* st) {
    XcdBarrier b; b.bar = bar; b.x = xb_xcc_id(); b.st = st;
    if (threadIdx.x == 0) (void)xb_add(&bar[XB_XCNT(b.x)], 1u);
    return b;
}
__device__ __forceinline__ void xcd_barrier_complete(unsigned* bar, unsigned x, unsigned& nloc, unsigned& nx) {
    const unsigned G = gridDim.x * gridDim.y * gridDim.z;
    unsigned sum, cnt, mine, sp = 0u;
    for (;;) {
        sum = 0u; cnt = 0u; mine = 0u;
#pragma unroll
        for (unsigned j = 0; j < 16; ++j) { const unsigned c = xb_ld(&bar[XB_XCNT(j)]); sum += c; cnt += (c > 0u) ? 1u : 0u; mine = (j == x) ? c : mine; }
        if (sum == G) break;
        __builtin_amdgcn_s_sleep(1);
        if ((++sp & 255u) == 0u) { if (xb_ld(&bar[XB_TMO])) break; if (sp > XB_SPIN_CAP) { atomicAdd(&bar[XB_TMO], 1u); break; } }
    }
    nloc = mine > 0u ? mine : 1u; nx = cnt > 0u ? cnt : 1u;
}

__device__ __forceinline__ void xcd_barrier(const XcdBarrier& b) {
    asm volatile("s_waitcnt vmcnt(0)" ::: "memory");
    __syncthreads();
    if (threadIdx.x == 0) {
        unsigned* bar = b.bar;
        __builtin_amdgcn_s_waitcnt(0);
        unsigned nloc = b.st[0], nx = b.st[1];
        if (nloc == 0u) { xcd_barrier_complete(bar, b.x, nloc, nx); b.st[0] = nloc; b.st[1] = nx; }
        const unsigned old = xb_add(&bar[XB_XSUB(b.x)], 1u);
        const unsigned gen = old / nloc;
        if (old + 1u == (gen + 1u) * nloc) {
            __builtin_amdgcn_fence(__ATOMIC_RELEASE, "agent");
            asm volatile("s_waitcnt vmcnt(0)" ::: "memory");
            const unsigned og = xb_add(&bar[XB_TOP], 1u);
            const unsigned tg = og / nx;
            if (og + 1u == (tg + 1u) * nx) xb_add(&bar[XB_TOPGEN], 1u);
            else XB_SPIN(xb_ld(&bar[XB_TOPGEN]) == tg, bar);
            __builtin_amdgcn_fence(__ATOMIC_ACQUIRE, "agent");
            xb_add(&bar[XB_XGEN(b.x)], 1u);
            asm volatile("s_waitcnt vmcnt(0)" ::: "memory");
        } else {
            XB_SPIN(xb_ld(&bar[XB_XGEN(b.x)]) == gen, bar);
            __builtin_amdgcn_fence(__ATOMIC_ACQUIRE, "agent");
            asm volatile("s_waitcnt vmcnt(0)" ::: "memory");
        }
    }
    __syncthreads();
}

struct Args {
    const float* x; const int* pos; const float* norm_mix_g; const float* w_in; const float* lq1; const float* lk1; const float* lq2; const float* lk2;
    const float* g_sb; const float* g_diff; const float* g_dil; const float* w_out; const float* norm_ffn_g; const float* w_gate; const float* w_up; const float* w_down;
    const float* norm_final_g; float* out; unsigned char* ws;
};

__global__ void __launch_bounds__(NTHREADS, 2) mega_fwd(Args a) {
    extern __shared__ __attribute__((aligned(16))) unsigned char lds_raw[];
    LAS unsigned char* lds = (LAS unsigned char*)lds_raw;
    volatile LAS unsigned* misc = (volatile LAS unsigned*)(lds + LDS_RING);
    cg::grid_group grid = cg::this_grid();
    if (threadIdx.x < 16) misc[threadIdx.x] = 0u;
    __syncthreads();
    (void)xcd_barrier_post((unsigned*)(a.ws + WS_CTL) + 1024, misc + 8);
#define GRID_SYNC() do { XcdBarrier xb_; xb_.bar = (unsigned*)(a.ws + WS_CTL) + 1024; xb_.x = xb_xcc_id(); xb_.st = misc + 8; xcd_barrier(xb_); } while (0)
#define FRESH_IDS() int tid = threadIdx.x; asm volatile("" : "+v"(tid)); const int lane = tid & 63, wid = __builtin_amdgcn_readfirstlane(tid >> 6); const int gw = blockIdx.x * NWAVES + wid; (void)lane; (void)gw
    const int G = gridDim.x, ngw = G * NWAVES;
#ifdef DIAG
#define STAMP(k) do { if (blockIdx.x == 0 && threadIdx.x == 0) misc[8 + (k)] = (unsigned)__builtin_amdgcn_s_memrealtime(); } while (0)
#else
#define STAMP(k) do {} while (0)
#endif
    STAMP(0);
    unsigned char* ws = a.ws;
    unsigned* ctl = (unsigned*)(ws + WS_CTL);
    pg8::f32x2* tabD = (pg8::f32x2*)(ws + WS_TAB);
    pg8::f32x2* tabL = (pg8::f32x2*)(ws + WS_TAB + 512 * 1024);
    bf16_t* XN = (bf16_t*)(ws + WS_XN); bf16_t* PROJ = (bf16_t*)(ws + WS_PROJ); bf16_t* HB = (bf16_t*)(ws + WS_PROJ); bf16_t* MIX = (bf16_t*)(ws + WS_MIX);
    unsigned long long* SSQ = (unsigned long long*)(ws + WS_CTL + 65536);
    float* DIFFO = (float*)(ws + WS_DIFFO); f32x2* ML = (f32x2*)(ws + WS_ML); float* DLSE = (float*)(ws + WS_DLSE);

#ifdef EXTRA_SYNCS
    for (int i = 0; i < EXTRA_SYNCS; ++i) grid.sync();
#endif
#ifdef EXTRA_BARS
    for (int i = 0; i < EXTRA_BARS; ++i) GRID_SYNC();
#endif
#ifndef PRO_REPS
#define PRO_REPS 1
#endif
    for (int rep = 0; rep < PRO_REPS; ++rep) {
        FRESH_IDS();
        LAS float* scr = (LAS float*)(lds + wid * 16384);
        constexpr int I_IN = 32 * 192, I_OUT = 32 * 64, I_GU = 32 * 352, I_DN = 88 * 64, I_L = I_IN + I_OUT + I_GU + I_DN;
#define PRO_DECODE(T, it_) do { T.valid = false; T.gk = nullptr; T.pk = 0; const int it__ = (it_); if (it__ < DEPTH * I_L) { const int L = it__ / I_L; int r = it__ % I_L; \
            if (r < I_IN) { const int kb = r / 192, nb = r % 192, dr0 = 32 * nb; \
                if (dr0 >= 1536 && dr0 < 2560) T.pk = ((dr0 & 63) == 0) ? 1 : 0; else if (dr0 >= 3072 && dr0 < 5120) T.pk = ((dr0 & 127) == 0) ? 2 : 0; \
                T.N = NPROJ; T.K = DM; T.k0 = 64 * kb; T.src = a.w_in + (size_t)L * DM * NPROJ + (size_t)T.k0 * NPROJ + dr0; \
                T.dst = (bf16_t*)(ws + WS_WIN) + (size_t)L * NPROJ * DM + (size_t)dr0 * DM + T.k0; T.gk = a.norm_mix_g + L * DM; T.valid = true; } \
            else { r -= I_IN; \
                if (!(L == 1 && (r < I_OUT + I_GU / 2 || r >= I_OUT + I_GU))) { \
                    if (r < I_OUT) { const int kb = r / 64, nb = r % 64; T.N = DM; T.K = DM; T.k0 = 64 * kb; \
                        T.src = a.w_out + (size_t)L * DM * DM + (size_t)T.k0 * DM + 32 * nb; T.dst = (bf16_t*)(ws + WS_WOUT) + (size_t)L * DM * DM + (size_t)(32 * nb) * DM + T.k0; T.valid = true; } \
                    else if (r < I_OUT + I_GU) { r -= I_OUT; const int kb = r / 352, nb = r % 352, dr0 = 32 * nb, tile = dr0 >> 8, within = dr0 & 255; \
                        T.N = DFF; T.K = DM; T.k0 = 64 * kb; T.src = ((within >> 7) ? a.w_up : a.w_gate) + (size_t)L * DM * DFF + (size_t)T.k0 * DFF + tile * 128 + (within & 127); \
                        T.dst = (bf16_t*)(ws + WS_WGU) + (size_t)L * NGU * DM + (size_t)dr0 * DM + T.k0; T.gk = a.norm_ffn_g + L * DM; T.valid = true; } \
                    else { r -= I_OUT + I_GU; const int kb = r / 64, nb = r % 64; T.N = DM; T.K = DFF; T.k0 = 64 * kb; \
                        T.src = a.w_down + (size_t)L * DFF * DM + (size_t)T.k0 * DM + 32 * nb; T.dst = (bf16_t*)(ws + WS_WDN) + (size_t)L * DM * DFF + (size_t)(32 * nb) * DFF + T.k0; T.valid = true; } } } } } while (0)
        {
            TrDesc dA, dB; float tvA[32], tvB[32];
            int it = gw;
            PRO_DECODE(dA, it); if (dA.valid) tr_load(dA, lane, tvA);
            while (it < DEPTH * I_L) {
                PRO_DECODE(dB, it + ngw); if (dB.valid) tr_load(dB, lane, tvB);
                if (dA.valid) tr_finish(dA, tvA, scr, lane);
                PRO_DECODE(dA, it + 2 * ngw); if (dA.valid) tr_load(dA, lane, tvA);
                if (dB.valid) tr_finish(dB, tvB, scr, lane);
                it += 2 * ngw;
            }
        }
#undef PRO_DECODE
        for (int idx = blockIdx.x * NTHREADS + tid; idx < MROWS * 24; idx += G * NTHREADS) {
            const int row = idx / 24, i = idx % 24;
            const float ang = (float)a.pos[row] * INVF[i];
            float s, c; sincos_acc(ang, s, c);
            if (i < 8) tabD[(size_t)row * 8 + i] = (pg8::f32x2){c, s}; else tabL[(size_t)row * 16 + (i - 8)] = (pg8::f32x2){c, s};
        }
        xb_rows(a.x, XN, SSQ, gw, ngw, lane);
    }
    if (a.ws == nullptr) grid.sync();
    GRID_SYNC(); STAMP(1);

    for (int L = 0; L < DEPTH; ++L) {
        {
            pg8::Gemm g{XN, (const bf16_t*)(ws + WS_WIN) + (size_t)L * NPROJ * DM, MROWS, NPROJ, DM};
            pg8::StaticOrder S; S.init(MROWS, NPROJ, G, (int)blockIdx.x);
            pg8::EpiProj E{PROJ, tabD, tabL, SSQ + (size_t)(2 * L) * MROWS};
#ifndef G1_REPS
#define G1_REPS 1
#endif
#ifndef G1_ALIGN
#define G1_ALIGN true
#endif
            for (int rep = 0; rep < G1_REPS; ++rep) { if (rep) GRID_SYNC(); pg8::gemm_phase<pg8::EpiProj, pg8::StaticOrder, G1_ALIGN, true>(lds, g, S, E); }
#ifdef G1_ALT
            { GRID_SYNC(); pg8::EpiSwiglu E2{(bf16_t*)DIFFO, SSQ + (size_t)(2 * L) * MROWS}; pg8::gemm_phase<pg8::EpiSwiglu, pg8::StaticOrder, true, true>(lds, g, S, E2); }
#endif
        }
        GRID_SYNC(); STAMP(2 + 8 * L + 0);
#ifndef ATT_REPS
#define ATT_REPS 1
#endif
        for (int rep = 0; rep < ATT_REPS; ++rep) {
            if (rep) GRID_SYNC();
            FRESH_IDS();
            unsigned* ctr = ctl + 64 * (1 + L + 2 * rep);
            for (;;) {
                int tid = threadIdx.x; asm volatile("" : "+v"(tid));
                const int lane = tid & 63;
                __syncthreads();
                if (tid == 0) misc[0] = atomicAdd(ctr, 1u);
                __syncthreads();
                const int idx = (int)misc[0];
                if (idx >= Q_TOTAL) break;
                int seg = 0;
#pragma unroll
                for (int sgi = 1; sgi < Q_NSEG; ++sgi) seg += (idx >= QSEG_START[sgi]) ? 1 : 0;
                const int kind = QSEG_KIND[seg], k = idx - QSEG_START[seg]; int qb = QSEG_QB[seg];
#ifdef ATT_REP_KIND
                if (rep > 0 && (kind & 1 ? 1 : kind) != ATT_REP_KIND) continue;
#endif
                if (kind == 0) {
                    qb = 15 - (k >> 3);
                    const int b = (k >> 2) & 1, head = k & 3;
                    f32x16 o[4]; float ls, mm;
                    causal_unit<0>(PROJ, b, qb, head * 128, 512 + head * 128, 1024 + head * 128, lds, tid, wid, lane, 0, 4 * (qb + 1), 0, 1, misc + 16, o, ls, mm);
                    const int qpos = qb * 256 + 32 * wid + (lane & 31);
                    (void)qpos;
                    stage_store_bf16(lds + wid * OST_WAVE, o, head_norm_scale(o), a.g_sb + L * 128, lane, MIX + ((size_t)b * SEQ + qb * 256 + 32 * wid) * DM + head * 128, DM);
                } else if (kind == 1 || kind == 3) {
                    const int split = (kind == 3) ? (k & 1) : 0, kk = (kind == 3) ? (k >> 1) : k;
                    const int comp = kk & 1, head = (kk >> 1) & 3, b = kk >> 3;
                    const int NTt = 4 * (qb + 1);
                    const int t_lo = (kind == 3 && split == 1) ? NTt / 2 : 0, t_hi = (kind == 3 && split == 0) ? NTt / 2 : NTt;
                    f32x16 o[4]; float ls, mm;
                    causal_unit<1>(PROJ, b, qb, 1536 + head * 128 + comp * 64, 2048 + head * 128 + comp * 64, 2560 + head * 128, lds, tid, wid, lane, t_lo, t_hi, 0, 1, misc + 16, o, ls, mm);
                    const int qpos = qb * 256 + 32 * wid + (lane & 31), h = lane >> 5;
                    const size_t row = (size_t)b * SEQ + qpos;
                    stage_store_bf16(lds + wid * OST_WAVE, o, 1.0f / ls, nullptr, lane, (bf16_t*)DIFFO + (size_t)(comp * 2 + split) * MROWS * 512 + ((size_t)b * SEQ + qb * 256 + 32 * wid) * 512 + head * 128, 512);
                    if (h == 0) ML[((size_t)(comp * 2 + split) * MROWS + row) * 4 + head] = (f32x2){mm, ls};
                } else {
                    const int u16 = k & 15, head = (k >> 4) & 7, b = (k >> 7) & 1, pat = k >> 8;
                    const int stride = pat == 0 ? 16 : (pat == 1 ? 4 : 1);
                    const int cls = u16 % stride, blk = u16 / stride;
                    const int t_hi = 4 * (blk + 1), t_lo = (4 * blk - 2) < 0 ? 0 : (4 * blk - 2);
                    f32x16 o[4]; float ls, mm;
                    causal_unit<2>(PROJ, b, blk, 3072 + head * 128, 4096 + head * 128, 5120 + head * 128, lds, tid, wid, lane, t_lo, t_hi, cls, stride, misc + 16, o, ls, mm);
                    const int qidx = blk * 256 + 32 * wid + (lane & 31), h = lane >> 5;
                    const size_t row = (size_t)b * SEQ + cls + (size_t)stride * qidx;
                    const float inv = 1.0f / ls;
                    bf16_t* dst0 = ((pat == 2) ? (bf16_t*)(ws + WS_DILP2) : (bf16_t*)a.out + (size_t)pat * MROWS * 1024) + ((size_t)b * SEQ + cls + (size_t)stride * (blk * 256 + 32 * wid)) * 1024 + head * 128;
                    stage_store_bf16(lds + wid * OST_WAVE, o, inv, nullptr, lane, dst0, (size_t)stride * 1024);
                    if (h == 0) DLSE[((size_t)pat * MROWS + row) * 8 + head] = mm + __builtin_amdgcn_logf(ls);
                }
            }
        }
        GRID_SYNC(); STAMP(2 + 8 * L + 1);
        {
            FRESH_IDS();
            const float lambda_init = (L == 0) ? 0.2f : 0.35550906759096934f;
            const float s1 = wave_sum(a.lq1[L * 64 + lane] * a.lk1[L * 64 + lane]), s2 = wave_sum(a.lq2[L * 64 + lane] * a.lk2[L * 64 + lane]);
            const float lam = expf(s1) - expf(s2) + lambda_init;
            const int grp = lane >> 4, l16 = lane & 15;
            const f32x4 gd0 = *(const f32x4*)(a.g_diff + L * 128 + 8 * l16), gd1 = *(const f32x4*)(a.g_diff + L * 128 + 8 * l16 + 4);
            for (int it = gw * 4 + grp; it < MROWS * 4; it += ngw * 4) {
                const int row = it >> 2, head = it & 3;
                const bool two = ((row & (SEQ - 1)) >= 2048);
                f32x4 on[2][2];
#pragma unroll
                for (int comp = 0; comp < 2; ++comp) {
                    const size_t i0 = (size_t)(comp * 2) * MROWS + row, i1 = i0 + MROWS;
                    const u32x4 w0 = *(const u32x4*)((const bf16_t*)DIFFO + i0 * 512 + head * 128 + 8 * l16);
                    f32x4 oa = (f32x4){__builtin_bit_cast(float, w0.x << 16), __builtin_bit_cast(float, w0.x & 0xffff0000u), __builtin_bit_cast(float, w0.y << 16), __builtin_bit_cast(float, w0.y & 0xffff0000u)};
                    f32x4 ob = (f32x4){__builtin_bit_cast(float, w0.z << 16), __builtin_bit_cast(float, w0.z & 0xffff0000u), __builtin_bit_cast(float, w0.w << 16), __builtin_bit_cast(float, w0.w & 0xffff0000u)};
                    if (two) {
                        const f32x2 ml0 = ML[i0 * 4 + head], ml1 = ML[i1 * 4 + head];
                        const u32x4 w1 = *(const u32x4*)((const bf16_t*)DIFFO + i1 * 512 + head * 128 + 8 * l16);
                        const f32x4 qa = (f32x4){__builtin_bit_cast(float, w1.x << 16), __builtin_bit_cast(float, w1.x & 0xffff0000u), __builtin_bit_cast(float, w1.y << 16), __builtin_bit_cast(float, w1.y & 0xffff0000u)};
                        const f32x4 qb_ = (f32x4){__builtin_bit_cast(float, w1.z << 16), __builtin_bit_cast(float, w1.z & 0xffff0000u), __builtin_bit_cast(float, w1.w << 16), __builtin_bit_cast(float, w1.w & 0xffff0000u)};
                        const float M = fmaxf(ml0.x, ml1.x); float a0 = ml0.y * __builtin_amdgcn_exp2f(ml0.x - M), a1 = ml1.y * __builtin_amdgcn_exp2f(ml1.x - M);
                        const float ia = 1.0f / (a0 + a1); a0 *= ia; a1 *= ia;
                        oa = oa * a0 + qa * a1; ob = ob * a0 + qb_ * a1;
                    }
                    on[comp][0] = oa; on[comp][1] = ob;
                }
                const f32x4 va = on[0][0] - lam * on[1][0], vb = on[0][1] - lam * on[1][1];
                float ss = (va.x * va.x + va.y * va.y) + (va.z * va.z + va.w * va.w) + (vb.x * vb.x + vb.y * vb.y) + (vb.z * vb.z + vb.w * vb.w);
                ss += __shfl_xor(ss, 1); ss += __shfl_xor(ss, 2); ss += __shfl_xor(ss, 4); ss += __shfl_xor(ss, 8);
                const float sc = (1.0f - lambda_init) / sqrtf(ss * (1.0f / 128.0f) + NORM_EPS);
                u32x4 w; w.x = pk2(va.x * sc * gd0.x, va.y * sc * gd0.y); w.y = pk2(va.z * sc * gd0.z, va.w * sc * gd0.w);
                w.z = pk2(vb.x * sc * gd1.x, vb.y * sc * gd1.y); w.w = pk2(vb.z * sc * gd1.z, vb.w * sc * gd1.w);
                *(u32x4*)(MIX + (size_t)row * DM + 512 + head * 128 + 8 * l16) = w;
            }
            const f32x4 gl0 = *(const f32x4*)(a.g_dil + L * 128 + 8 * l16), gl1 = *(const f32x4*)(a.g_dil + L * 128 + 8 * l16 + 4);
            for (int it = gw * 4 + grp; it < MROWS * 8; it += ngw * 4) {
                const int row = it >> 3, head = it & 7;
                float lse[3]; u32x4 pw[3];
#pragma unroll
                for (int p = 0; p < 3; ++p) { lse[p] = DLSE[((size_t)p * MROWS + row) * 8 + head];
                    const bf16_t* src = (p == 2) ? (const bf16_t*)(ws + WS_DILP2) : (const bf16_t*)a.out + (size_t)p * MROWS * 1024;
                    pw[p] = *(const u32x4*)(src + (size_t)row * 1024 + head * 128 + 8 * l16); }
                const float M = fmaxf(fmaxf(lse[0], lse[1]), lse[2]);
                float w0 = __builtin_amdgcn_exp2f(lse[0] - M), w1 = __builtin_amdgcn_exp2f(lse[1] - M), w2 = __builtin_amdgcn_exp2f(lse[2] - M);
                const float iw = 1.0f / (w0 + w1 + w2); w0 *= iw; w1 *= iw; w2 *= iw;
                float v[8]; float ss = 0.f;
#pragma unroll
                for (int e = 0; e < 4; ++e) {
                    const unsigned u0 = pw[0][e], u1 = pw[1][e], u2 = pw[2][e];
                    v[2 * e] = __builtin_bit_cast(float, u0 << 16) * w0 + __builtin_bit_cast(float, u1 << 16) * w1 + __builtin_bit_cast(float, u2 << 16) * w2;
                    v[2 * e + 1] = __builtin_bit_cast(float, u0 & 0xffff0000u) * w0 + __builtin_bit_cast(float, u1 & 0xffff0000u) * w1 + __builtin_bit_cast(float, u2 & 0xffff0000u) * w2;
                    ss += v[2 * e] * v[2 * e] + v[2 * e + 1] * v[2 * e + 1];
                }
                ss += __shfl_xor(ss, 1); ss += __shfl_xor(ss, 2); ss += __shfl_xor(ss, 4); ss += __shfl_xor(ss, 8);
                const float sc = 1.0f / sqrtf(ss * (1.0f / 128.0f) + NORM_EPS);
                u32x4 w; w.x = pk2(v[0] * sc * gl0.x, v[1] * sc * gl0.y); w.y = pk2(v[2] * sc * gl0.z, v[3] * sc * gl0.w);
                w.z = pk2(v[4] * sc * gl1.x, v[5] * sc * gl1.y); w.w = pk2(v[6] * sc * gl1.z, v[7] * sc * gl1.w);
                *(u32x4*)(MIX + (size_t)row * DM + 1024 + head * 128 + 8 * l16) = w;
            }
        }
        GRID_SYNC(); STAMP(2 + 8 * L + 2);
        {
            pg8::Gemm g{MIX, (const bf16_t*)(ws + WS_WOUT) + (size_t)L * DM * DM, MROWS, DM, DM};
            pg8::StaticOrder S; S.init(MROWS, DM, G, (int)blockIdx.x);
            pg8::EpiResidNormB E{XN, SSQ + (size_t)(2 * L + 1) * MROWS};
            pg8::gemm_phase<pg8::EpiResidNormB, pg8::StaticOrder, true, true>(lds, g, S, E);
#ifdef G2_REPS
            { GRID_SYNC(); pg8::EpiResid E2{a.x, DIFFO}; pg8::gemm_phase<pg8::EpiResid, pg8::StaticOrder, true, true>(lds, g, S, E2); }
#endif
        }
        GRID_SYNC(); STAMP(2 + 8 * L + 3);
        {
            pg8::Gemm g{XN, (const bf16_t*)(ws + WS_WGU) + (size_t)L * NGU * DM, MROWS, NGU, DM};
            pg8::StaticOrder S; S.init(MROWS, NGU, G, (int)blockIdx.x);
            pg8::EpiSwiglu E{HB, SSQ + (size_t)(2 * L + 1) * MROWS};
#ifndef G3_REPS
#define G3_REPS 1
#endif
            for (int rep = 0; rep < G3_REPS; ++rep) { if (rep) GRID_SYNC(); pg8::gemm_phase<pg8::EpiSwiglu, pg8::StaticOrder, true, true>(lds, g, S, E); }
            if (DEPTH > 1 && (int)blockIdx.x * 2 >= G) {
                FRESH_IDS();
                LAS float* scr = (LAS float*)(lds + wid * 16384);
                const int hw = ((int)blockIdx.x - G / 2) * NWAVES + wid, nhw = (G - G / 2) * NWAVES;
                constexpr int J_OUT = 32 * 64, J_GUH = 16 * 352, J_DN = 88 * 64;
                if (L == 0) {
                    for (int r = hw; r < J_OUT + J_GUH; r += nhw) {
                        if (r < J_OUT) { const int kb = r / 64, nb = r % 64;
                            tr_item(a.w_out + (size_t)DM * DM, DM, DM, 32 * nb, 0, (bf16_t*)(ws + WS_WOUT) + (size_t)DM * DM, 32 * nb, 64 * kb, scr, lane); }
                        else { const int r2 = r - J_OUT, kb = r2 / 352, nb = r2 % 352, dr0 = 32 * nb, tile = dr0 >> 8, within = dr0 & 255;
                            const float* src = (within >> 7) ? a.w_up : a.w_gate;
                            tr_item(src + (size_t)DM * DFF, DM, DFF, tile * 128 + (within & 127), 0, (bf16_t*)(ws + WS_WGU) + (size_t)NGU * DM, dr0, 64 * kb, scr, lane, a.norm_ffn_g + DM); }
                    }
                } else if (L == 1) {
                    for (int r = hw; r < J_DN; r += nhw) { const int kb = r / 64, nb = r % 64;
                        tr_item(a.w_down + (size_t)DFF * DM, DFF, DM, 32 * nb, 0, (bf16_t*)(ws + WS_WDN) + (size_t)DM * DFF, 32 * nb, 64 * kb, scr, lane); }
                }
            }
        }
        GRID_SYNC(); STAMP(2 + 8 * L + 5);
        {
            pg8::Gemm g{HB, (const bf16_t*)(ws + WS_WDN) + (size_t)L * DM * DFF, MROWS, DM, DFF};
            pg8::StaticOrder S; S.init(MROWS, DM, G, (int)blockIdx.x);
            if (L + 1 < DEPTH) { pg8::EpiResidNormB E{XN, SSQ + (size_t)(2 * L + 2) * MROWS}; pg8::gemm_phase<pg8::EpiResidNormB, pg8::StaticOrder, true, true>(lds, g, S, E); }
            else { pg8::EpiResidB2F E{XN, a.out}; pg8::gemm_phase<pg8::EpiResidB2F, pg8::StaticOrder, true, true>(lds, g, S, E); }
#ifdef G4_REPS
            { GRID_SYNC(); pg8::EpiResid E2{a.out, DIFFO}; pg8::gemm_phase<pg8::EpiResid, pg8::StaticOrder, true, true>(lds, g, S, E2); }
#endif
        }
        GRID_SYNC(); STAMP(2 + 8 * L + 6);
        if (L + 1 == DEPTH) { FRESH_IDS(); rms_rows_f32_inplace(a.out, a.norm_final_g, gw, ngw, lane); }
    }
#ifdef DIAG
    GRID_SYNC(); STAMP(20);
    if (blockIdx.x == 0) {
        __syncthreads();
        const float t1 = (float)(misc[8 + DIAG_T1B] - misc[8 + DIAG_T1A]) * 0.01f;
        const float t2 = (float)(misc[8 + DIAG_T2B] - misc[8 + DIAG_T2A]) * 0.01f;
        for (int i = threadIdx.x; i < (1 << 20); i += NTHREADS) a.out[i] += t2 * 0.25f;
        if (threadIdx.x == 0) a.out[(size_t)8191 * DM] += t1;
    }
#endif
}

extern "C" void kernel_launch(void* const* d_in, const int* in_sizes, int n_in, void* d_out, int out_size, void* d_ws, size_t ws_size, hipStream_t stream) {
    static int grid = 0;
    if (grid == 0) {
        if (n_in != 17 || out_size != MROWS * DM || ws_size < WS_END) { fprintf(stderr, "kernel_launch: unexpected shapes (n_in %d out %d ws %zu)\n", n_in, out_size, ws_size); grid = -1; return; }
        int dev = 0, cus = 0, per_cu = 0;
        hipGetDevice(&dev); hipDeviceGetAttribute(&cus, hipDeviceAttributeMultiprocessorCount, dev);
        if (hipFuncSetAttribute((const void*)mega_fwd, hipFuncAttributeMaxDynamicSharedMemorySize, LDS_BYTES) != hipSuccess) { fprintf(stderr, "kernel_launch: hipFuncSetAttribute failed\n"); }
        hipOccupancyMaxActiveBlocksPerMultiprocessor(&per_cu, (const void*)mega_fwd, NTHREADS, LDS_BYTES);
        (void)hipGetLastError();
        if (per_cu < 1) { fprintf(stderr, "kernel_launch: occupancy query says %d blocks per CU\n", per_cu); per_cu = 1; }
        grid = cus;
    }
    if (grid < 0) return;
    hipMemsetAsync((char*)d_ws + WS_CTL, 0, 65536 + 4 * MROWS * 8, stream);
    Args a{};
    a.x = (const float*)d_in[0]; a.pos = (const int*)d_in[1]; a.norm_mix_g = (const float*)d_in[2]; a.w_in = (const float*)d_in[3];
    a.lq1 = (const float*)d_in[4]; a.lk1 = (const float*)d_in[5]; a.lq2 = (const float*)d_in[6]; a.lk2 = (const float*)d_in[7];
    a.g_sb = (const float*)d_in[8]; a.g_diff = (const float*)d_in[9]; a.g_dil = (const float*)d_in[10]; a.w_out = (const float*)d_in[11];
    a.norm_ffn_g = (const float*)d_in[12]; a.w_gate = (const float*)d_in[13]; a.w_up = (const float*)d_in[14]; a.w_down = (const float*)d_in[15];
    a.norm_final_g = (const float*)d_in[16]; a.out = (float*)d_out; a.ws = (unsigned char*)d_ws;
    void* args[] = {&a};
    hipError_t e = hipLaunchCooperativeKernel((const void*)mega_fwd, dim3(grid), dim3(NTHREADS), args, LDS_BYTES, stream);
    if (e != hipSuccess) fprintf(stderr, "kernel_launch: cooperative launch failed: %s (grid %d)\n", hipGetErrorString(e), grid);
}
```

```cpp
#include <hip/hip_runtime.h>
#include <hip/hip_cooperative_groups.h>
#include <cstdio>
#include <cstdint>
#include <cmath>
namespace cg = cooperative_groups;
namespace pg8 {
#define PG8_LAS __attribute__((address_space(3)))
typedef unsigned short bf16_t;
typedef short bf16x8 __attribute__((ext_vector_type(8)));
typedef float f32x4 __attribute__((ext_vector_type(4)));
typedef unsigned u32x4 __attribute__((ext_vector_type(4)));
constexpr int BM = 256, BK = 64, HALF = 128, HTB = HALF * BK * 2  , STAGE_BYTES = 8 * HTB, NXCD = 8, WGM = 8;

__host__ __device__ __forceinline__ int lds_byte(int r, int c) { const int st = (r >> 4) * 2 + (c >> 5), rr = r & 15, cc = c & 31, ob = rr * 64 + cc * 2; return st * 1024 + (ob ^ (((ob >> 9) & 1) << 5)); }
__host__ __device__ __forceinline__ void stage_rc(int b, int& R, int& C) { const int st = b / 1024, sb = b % 1024, swz = sb ^ (((sb >> 9) & 1) << 5); R = (st >> 1) * 16 + swz / 64; C = (st & 1) * 32 + (swz % 64) / 2; }
__host__ __device__ __forceinline__ int perm32(int rho) { const int n = rho >> 4, i = rho & 15; return 8 * (i >> 2) + 4 * n + (i & 3); }

struct Unit { int pm, pn; };
struct Gemm { const bf16_t* A; const bf16_t* Bt; int M, N, K; };

struct StaticOrder {
    int nM, nN, nwg, G, c;
    __host__ __device__ void init(int M, int N, int G_, int c_) { nM = M / BM; nN = N / BM; nwg = nM * nN; G = G_; c = c_; }
    __host__ __device__ bool next(int i, Unit& u) const {
        const long L = (long)i * G + c; if (L >= nwg) return false;
        int wgid = (int)L; { const int q = nwg / NXCD, r = nwg % NXCD, xcd = wgid % NXCD, off = wgid / NXCD; wgid = (xcd < r ? xcd * (q + 1) : r * (q + 1) + (xcd - r) * q) + off; }
        const int nig = WGM * nN, gid = wgid / nig, fm = gid * WGM, gsz = (nM - fm) < WGM ? (nM - fm) : WGM;
        u.pm = fm + ((wgid % nig) % gsz); u.pn = (wgid % nig) / gsz; return true;
    }
    __device__ __forceinline__ void a_ready(const Unit&) const {}
    __device__ __forceinline__ void done(const Unit&) const {}
};
__device__ __forceinline__ unsigned cvt_pk_bf16(float lo, float hi) { unsigned r; asm volatile("v_cvt_pk_bf16_f32 %0, %1, %2" : "=v"(r) : "v"(lo), "v"(hi)); return r; }
typedef float f32x2 __attribute__((ext_vector_type(2)));
template <class Epi, class Sched, bool ALIGN_EPI = false, bool SP2 = false>
__device__ __forceinline__ void gemm_phase(PG8_LAS unsigned char* lds, const Gemm g, const Sched& S, const Epi& E) {
    int tid_ = threadIdx.x; asm volatile("" : "+v"(tid_));
    const int tid = tid_, wid = __builtin_amdgcn_readfirstlane(tid >> 6), lane = tid & 63, wr = wid >> 2, wc = wid & 3, fr = lane & 15, fq = lane >> 4;
    const int K = g.K, nt = K / BK;
    unsigned voffA[2], voffB[2];
#pragma unroll
    for (int i = 0; i < 2; ++i) { int R, C; stage_rc(tid * 16 + i * 8192, R, C); const int Rb = Epi::PERM ? ((R & ~31) + perm32(R & 31)) : R;
        voffA[i] = (unsigned)(R * K + C) * 2u; voffB[i] = (unsigned)(Rb * K + C) * 2u; }
    const size_t kstep = (size_t)(BK * 2);
    const size_t hstep = (size_t)HALF * K * 2;
    const size_t tstep = 2 * hstep;
    const unsigned ldsw = (unsigned)wid * 1024u;
    const int aoff = lds_byte(wr * 64 + fr, fq * 8), boff = lds_byte(wc * 32 + fr, fq * 8);
#define PG8_SA(b, h) (((b) * 2 + (h)) * HTB)
#define PG8_SB(b, h) ((4 + (b) * 2 + (h)) * HTB)
#define PG8_STAGE(bufoff, gbase, voff) do { _Pragma("unroll") for (int _i = 0; _i < 2; ++_i) \
        __builtin_amdgcn_global_load_lds((const unsigned*)((const char*)(gbase) + (voff)[_i]), (PG8_LAS unsigned*)(lds + (bufoff) + ldsw + _i * 8192), 16, 0, 0); } while (0)
#define PG8_LDA(dst, b, h) do { _Pragma("unroll") for (int m = 0; m < 4; ++m) _Pragma("unroll") for (int k = 0; k < 2; ++k) dst[m][k] = *(const PG8_LAS bf16x8*)(lds + PG8_SA(b, h) + aoff + m * 2048 + k * 1024); } while (0)
#define PG8_LDB(dst, b, h) do { _Pragma("unroll") for (int n = 0; n < 2; ++n) _Pragma("unroll") for (int k = 0; k < 2; ++k) dst[n][k] = *(const PG8_LAS bf16x8*)(lds + PG8_SB(b, h) + boff + n * 2048 + k * 1024); } while (0)
#define PG8_MMA(ai, bj, At, Bt) do { __builtin_amdgcn_s_setprio(1); _Pragma("unroll") for (int m = 0; m < 4; ++m) _Pragma("unroll") for (int n = 0; n < 2; ++n) _Pragma("unroll") for (int k = 0; k < 2; ++k) \
        acc[ai][bj][m][n] = __builtin_amdgcn_mfma_f32_16x16x32_bf16(Bt[n][k], At[m][k], acc[ai][bj][m][n], 0, 0, 0); __builtin_amdgcn_s_setprio(0); } while (0)
#define PG8_WAIT_V(n) asm volatile("s_waitcnt vmcnt(" #n ")" ::: "memory")
#define PG8_WAIT_L(n) asm volatile("s_waitcnt lgkmcnt(" #n ")" ::: "memory")
#define PG8_BAR __builtin_amdgcn_s_barrier()
#define PG8_SCHED __builtin_amdgcn_sched_barrier(0)
    Unit cur, nxt; int ui = 0;
    if (!S.next(0, cur)) return;
    f32x4 acc[2][2][4][2];
#pragma unroll
    for (int a = 0; a < 2; ++a)
#pragma unroll
        for (int b = 0; b < 2; ++b)
#pragma unroll
            for (int m = 0; m < 4; ++m)
#pragma unroll
                for (int n = 0; n < 2; ++n) acc[a][b][m][n] = (f32x4){0.f, 0.f, 0.f, 0.f};
    bf16x8 At[4][2], B0[2][2], B1[2][2];
    const char* cA = (const char*)g.A + (size_t)cur.pm * tstep; const char* cB = (const char*)g.Bt + (size_t)cur.pn * tstep;
    S.a_ready(cur);
    if constexpr (SP2) {
        PG8_STAGE(PG8_SB(0, 0), cB, voffB); PG8_STAGE(PG8_SB(0, 1), cB + hstep, voffB); PG8_STAGE(PG8_SA(0, 0), cA, voffA); PG8_STAGE(PG8_SA(0, 1), cA + hstep, voffA);
        if (wr == 1) PG8_BAR;
        PG8_WAIT_V(2); PG8_BAR;
        PG8_STAGE(PG8_SB(1, 0), cB + kstep, voffB); PG8_STAGE(PG8_SA(1, 0), cA + kstep, voffA); PG8_STAGE(PG8_SB(1, 1), cB + hstep + kstep, voffB);
        PG8_WAIT_V(6); PG8_BAR;
    } else {
        PG8_STAGE(PG8_SB(0, 0), cB, voffB); PG8_STAGE(PG8_SA(0, 0), cA, voffA); PG8_STAGE(PG8_SB(0, 1), cB + hstep, voffB); PG8_STAGE(PG8_SA(0, 1), cA + hstep, voffA);
        if (wr == 1) PG8_BAR;
        PG8_WAIT_V(4); PG8_BAR;
        PG8_STAGE(PG8_SB(1, 0), cB + kstep, voffB); PG8_STAGE(PG8_SA(1, 0), cA + kstep, voffA); PG8_STAGE(PG8_SB(1, 1), cB + hstep + kstep, voffB);
        PG8_WAIT_V(6); PG8_BAR;
    }
    for (;;) {
        const bool has_next = S.next(ui + 1, nxt);
        const char* nA = has_next ? (const char*)g.A + (size_t)nxt.pm * tstep : cA; const char* nB = has_next ? (const char*)g.Bt + (size_t)nxt.pn * tstep : cB;
        for (int t = 0; t < nt; t += 2) {
            const bool last = (t == nt - 2);
            const char* a1 = cA + (size_t)(t + 1) * kstep;
            const char* a2 = last ? nA : cA + (size_t)(t + 2) * kstep; const char* b2 = last ? nB : cB + (size_t)(t + 2) * kstep;
            const char* a3 = a2 + kstep; const char* b3 = b2 + kstep;
            if (last && has_next) S.a_ready(nxt);
            if constexpr (SP2) {
            PG8_LDB(B0, 0, 0); PG8_LDB(B1, 0, 1); PG8_SCHED; PG8_LDA(At, 0, 0); PG8_STAGE(PG8_SA(1, 1), a1 + hstep, voffA);
            PG8_WAIT_V(8); PG8_WAIT_L(0); PG8_BAR; PG8_MMA(0, 0, At, B0); PG8_MMA(0, 1, At, B1); PG8_BAR; PG8_SCHED;
            PG8_LDA(At, 0, 1); PG8_STAGE(PG8_SB(0, 0), b2, voffB); PG8_STAGE(PG8_SB(0, 1), b2 + hstep, voffB); PG8_STAGE(PG8_SA(0, 0), a2, voffA);
            PG8_WAIT_V(8); PG8_WAIT_L(0); PG8_BAR; PG8_MMA(1, 0, At, B0); PG8_MMA(1, 1, At, B1); PG8_BAR; PG8_SCHED;
            PG8_LDB(B0, 1, 0); PG8_LDB(B1, 1, 1); PG8_SCHED; PG8_LDA(At, 1, 0); PG8_STAGE(PG8_SA(0, 1), a2 + hstep, voffA);
            PG8_WAIT_V(8); PG8_WAIT_L(0); PG8_BAR; PG8_MMA(0, 0, At, B0); PG8_MMA(0, 1, At, B1); PG8_BAR; PG8_SCHED;
            PG8_LDA(At, 1, 1); PG8_STAGE(PG8_SB(1, 0), b3, voffB); PG8_STAGE(PG8_SB(1, 1), b3 + hstep, voffB); PG8_STAGE(PG8_SA(1, 0), a3, voffA);
            PG8_WAIT_V(8); PG8_WAIT_L(0); PG8_BAR; PG8_MMA(1, 0, At, B0); PG8_MMA(1, 1, At, B1); PG8_BAR; PG8_SCHED;
            } else {
            PG8_LDB(B0, 0, 0); PG8_SCHED; PG8_LDA(At, 0, 0); PG8_STAGE(PG8_SA(1, 1), a1 + hstep, voffA);
            PG8_WAIT_L(8); PG8_BAR; PG8_WAIT_L(0); PG8_MMA(0, 0, At, B0); PG8_BAR; PG8_SCHED;
            PG8_LDB(B1, 0, 1); PG8_STAGE(PG8_SB(0, 0), b2, voffB);
            PG8_BAR; PG8_WAIT_L(0); PG8_MMA(0, 1, At, B1); PG8_BAR;
            PG8_LDA(At, 0, 1); PG8_STAGE(PG8_SA(0, 0), a2, voffA);
            PG8_BAR; PG8_WAIT_L(0); PG8_MMA(1, 0, At, B0); PG8_BAR; PG8_SCHED;
            PG8_STAGE(PG8_SB(0, 1), b2 + hstep, voffB);
            PG8_WAIT_V(6); PG8_BAR; PG8_MMA(1, 1, At, B1); PG8_BAR;
            PG8_LDB(B0, 1, 0); PG8_SCHED; PG8_LDA(At, 1, 0); PG8_STAGE(PG8_SA(0, 1), a2 + hstep, voffA);
            PG8_WAIT_L(8); PG8_BAR; PG8_WAIT_L(0); PG8_MMA(0, 0, At, B0); PG8_BAR; PG8_SCHED;
            PG8_LDB(B1, 1, 1); PG8_STAGE(PG8_SB(1, 0), b3, voffB);
            PG8_BAR; PG8_WAIT_L(0); PG8_MMA(0, 1, At, B1); PG8_BAR;
            PG8_LDA(At, 1, 1); PG8_STAGE(PG8_SA(1, 0), a3, voffA);
            PG8_BAR; PG8_WAIT_L(0); PG8_MMA(1, 0, At, B0); PG8_BAR; PG8_SCHED;
            PG8_STAGE(PG8_SB(1, 1), b3 + hstep, voffB);
            PG8_WAIT_V(6); PG8_BAR; PG8_MMA(1, 1, At, B1); PG8_BAR;
            }
        }
        if constexpr (ALIGN_EPI) { if (wr == 0) PG8_BAR; }
        if constexpr (!Epi::AFTER_DRAIN) { E(acc, cur, wr, wc, fr, fq); S.done(cur); }
        if (!has_next) break;
#pragma unroll
        for (int a = 0; a < 2; ++a)
#pragma unroll
            for (int b = 0; b < 2; ++b)
#pragma unroll
                for (int m = 0; m < 4; ++m)
#pragma unroll
                    for (int n = 0; n < 2; ++n) acc[a][b][m][n] = (f32x4){0.f, 0.f, 0.f, 0.f};
        cur = nxt; cA = nA; cB = nB; ++ui;
        if constexpr (ALIGN_EPI) { if (wr == 1) PG8_BAR; }
    }
    PG8_WAIT_V(0);
    if constexpr (!ALIGN_EPI) { if (wr == 0) PG8_BAR; }
    PG8_BAR;
    if constexpr (Epi::AFTER_DRAIN) { E.fused(acc, cur, wr, wc, fr, fq, lds, wid, lane); S.done(cur); }
#undef PG8_SA
#undef PG8_SB
#undef PG8_STAGE
#undef PG8_LDA
#undef PG8_LDB
#undef PG8_MMA
#undef PG8_WAIT_V
#undef PG8_WAIT_L
#undef PG8_BAR
#undef PG8_SCHED
}
constexpr float SC128 = 0.12751743082459868f;
constexpr float SC64  = 0.18033688011112042f;
constexpr int LDP = 6144, LDH = 5632, LDX = 2048;
typedef float f32x2 __attribute__((ext_vector_type(2)));

__device__ __forceinline__ float rstd_of(const unsigned long long* ssq, int row) {
    return __builtin_amdgcn_rsqf((float)ssq[row] * (9.5367431640625e-07f / 2048.0f) + 1e-6f);
}
__device__ __forceinline__ float rstd_from(unsigned long long s) { return __builtin_amdgcn_rsqf((float)s * (9.5367431640625e-07f / 2048.0f) + 1e-6f); }
struct EpiProj {
    static constexpr bool PERM = true, AFTER_DRAIN = false;
    bf16_t* O; const f32x2* tabD; const f32x2* tabL; const unsigned long long* ssq;
    __device__ __forceinline__ void operator()(const f32x4 (&acc)[2][2][4][2], const Unit& u, int wr, int wc, int fr, int fq) const {
        const int pn = u.pn;
        int kind = 0; float sc = 1.f;
        if (pn < 2) sc = SC128;
        else if (pn >= 6 && pn < 10) { kind = 1; if (pn < 8) sc = SC64; }
        else if (pn >= 12 && pn < 20) { kind = 2; if (pn < 16) sc = SC128; }
        const int row0 = u.pm * BM + wr * 64 + fr;
        const int cl = wc * 32 + 8 * fq;
        const bool ropeD = (kind == 1) && ((wc & 1) == 0) && (fq < 2);
        const bool ropeL = (kind == 2) && (wc == 0);
        const bool rope = ropeD || ropeL;
        const int i0 = 4 * fq;
#pragma unroll
        for (int ai = 0; ai < 2; ++ai) {
            unsigned long long sq[4]; f32x4 cs0[4], cs1[4];
#pragma unroll
            for (int m = 0; m < 4; ++m) { const int row = row0 + ai * HALF + m * 16; sq[m] = ssq[row];
                cs0[m] = (f32x4){1.f, 0.f, 1.f, 0.f}; cs1[m] = (f32x4){1.f, 0.f, 1.f, 0.f};
                if (ropeD) { const f32x4* t = (const f32x4*)(tabD + (size_t)row * 8 + i0); cs0[m] = t[0]; cs1[m] = t[1]; }
                else if (ropeL) { const f32x4* t = (const f32x4*)(tabL + (size_t)row * 16 + i0); cs0[m] = t[0]; cs1[m] = t[1]; } }
            __builtin_amdgcn_sched_barrier(0);
#pragma unroll
            for (int m = 0; m < 4; ++m) {
                const int row = row0 + ai * HALF + m * 16;
                bf16_t* rowp = O + (size_t)row * LDP + pn * BM + cl;
                const float rs = rstd_from(sq[m]);
#pragma unroll
                for (int bj = 0; bj < 2; ++bj) {
                    f32x4 v0 = acc[ai][bj][m][0] * rs, v1 = acc[ai][bj][m][1] * rs;
                    if (rope) {
                        f32x4 w0, w1;
                        w0[0] = v0[0] * cs0[m][0] - v0[1] * cs0[m][1]; w0[1] = v0[1] * cs0[m][0] + v0[0] * cs0[m][1];
                        w0[2] = v0[2] * cs0[m][2] - v0[3] * cs0[m][3]; w0[3] = v0[3] * cs0[m][2] + v0[2] * cs0[m][3];
                        w1[0] = v1[0] * cs1[m][0] - v1[1] * cs1[m][1]; w1[1] = v1[1] * cs1[m][0] + v1[0] * cs1[m][1];
                        w1[2] = v1[2] * cs1[m][2] - v1[3] * cs1[m][3]; w1[3] = v1[3] * cs1[m][2] + v1[2] * cs1[m][3];
                        v0 = w0; v1 = w1;
                    }
                    v0 = v0 * sc; v1 = v1 * sc;
                    u32x4 w; w.x = cvt_pk_bf16(v0[0], v0[1]); w.y = cvt_pk_bf16(v0[2], v0[3]); w.z = cvt_pk_bf16(v1[0], v1[1]); w.w = cvt_pk_bf16(v1[2], v1[3]);
                    *(u32x4*)(rowp + bj * HALF) = w;
                }
            }
        }
    }
};

struct EpiSwiglu {
    static constexpr bool PERM = true, AFTER_DRAIN = false;
    bf16_t* O; const unsigned long long* ssq;
    __device__ __forceinline__ float act(float g, float u) const {
        const float e = __builtin_amdgcn_exp2f(-1.4426950408889634f * g);
        return g * u * __builtin_amdgcn_rcpf(1.0f + e);
    }
    __device__ __forceinline__ void operator()(const f32x4 (&acc)[2][2][4][2], const Unit& u, int wr, int wc, int fr, int fq) const {
        const int row0 = u.pm * BM + wr * 64 + fr;
        const int col0 = u.pn * HALF + wc * 32 + 8 * fq;
        unsigned long long sq[2][4];
#pragma unroll
        for (int ai = 0; ai < 2; ++ai)
#pragma unroll
            for (int m = 0; m < 4; ++m) sq[ai][m] = ssq[row0 + ai * HALF + m * 16];
        __builtin_amdgcn_sched_barrier(0);
#pragma unroll
        for (int ai = 0; ai < 2; ++ai)
#pragma unroll
            for (int m = 0; m < 4; ++m) {
                bf16_t* rowp = O + (size_t)(row0 + ai * HALF + m * 16) * LDH + col0;
                const float rs = rstd_from(sq[ai][m]);
                const f32x4 g0 = acc[ai][0][m][0] * rs, g1 = acc[ai][0][m][1] * rs, u0 = acc[ai][1][m][0] * rs, u1 = acc[ai][1][m][1] * rs;
                u32x4 w;
                w.x = cvt_pk_bf16(act(g0[0], u0[0]), act(g0[1], u0[1])); w.y = cvt_pk_bf16(act(g0[2], u0[2]), act(g0[3], u0[3]));
                w.z = cvt_pk_bf16(act(g1[0], u1[0]), act(g1[1], u1[1])); w.w = cvt_pk_bf16(act(g1[2], u1[2]), act(g1[3], u1[3]));
                *(u32x4*)rowp = w;
            }
    }
};

struct EpiResid {
    static constexpr bool PERM = true, AFTER_DRAIN = false;
    const float* base; float* out;
    __device__ __forceinline__ void operator()(const f32x4 (&acc)[2][2][4][2], const Unit& u, int wr, int wc, int fr, int fq) const {
        const int row0 = u.pm * BM + wr * 64 + fr;
        const int col0 = u.pn * BM + wc * 32 + 8 * fq;
#pragma unroll
        for (int ai = 0; ai < 2; ++ai)
#pragma unroll
            for (int m = 0; m < 4; ++m) {
                const size_t off = (size_t)(row0 + ai * HALF + m * 16) * LDX + col0;
#pragma unroll
                for (int bj = 0; bj < 2; ++bj)
#pragma unroll
                    for (int n = 0; n < 2; ++n) {
                        const f32x4 b = *(const f32x4*)(base + off + bj * HALF + n * 4);
                        *(f32x4*)(out + off + bj * HALF + n * 4) = b + acc[ai][bj][m][n];
                    }
            }
    }
};
struct EpiResidNorm {
    static constexpr bool PERM = true, AFTER_DRAIN = false;
    const float* base; float* out; bf16_t* xb; unsigned long long* ssq;
    __device__ __forceinline__ void operator()(const f32x4 (&acc)[2][2][4][2], const Unit& u, int wr, int wc, int fr, int fq) const {
        const int row0 = u.pm * BM + wr * 64 + fr;
        const int col0 = u.pn * BM + wc * 32 + 8 * fq;
#pragma unroll
        for (int ai = 0; ai < 2; ++ai)
#pragma unroll
            for (int m = 0; m < 4; ++m) {
                const int row = row0 + ai * HALF + m * 16;
                const size_t off = (size_t)row * LDX + col0;
                float ss = 0.f;
#pragma unroll
                for (int bj = 0; bj < 2; ++bj)
#pragma unroll
                    for (int n = 0; n < 2; ++n) {
                        const f32x4 b = *(const f32x4*)(base + off + bj * HALF + n * 4);
                        const f32x4 v = b + acc[ai][bj][m][n];
                        *(f32x4*)(out + off + bj * HALF + n * 4) = v;
                        ss += (v[0] * v[0] + v[1] * v[1]) + (v[2] * v[2] + v[3] * v[3]);
                        unsigned lo = cvt_pk_bf16(v[0], v[1]), hi = cvt_pk_bf16(v[2], v[3]);
                        *(unsigned long long*)(xb + off + bj * HALF + n * 4) = (unsigned long long)lo | ((unsigned long long)hi << 32);
                    }
                ss += __shfl_xor(ss, 16); ss += __shfl_xor(ss, 32);
                if (fq == 0) atomicAdd(ssq + row, (unsigned long long)(ss * 1048576.0f));
            }
    }
};
__device__ __forceinline__ f32x4 bf4_to_f32(unsigned long long w) {
    const unsigned lo = (unsigned)w, hi = (unsigned)(w >> 32);
    return (f32x4){__builtin_bit_cast(float, lo << 16), __builtin_bit_cast(float, lo & 0xffff0000u), __builtin_bit_cast(float, hi << 16), __builtin_bit_cast(float, hi & 0xffff0000u)};
}
struct EpiResidNormB {
    static constexpr bool PERM = true, AFTER_DRAIN = false;
    bf16_t* xb; unsigned long long* ssq;
    __device__ __forceinline__ void operator()(const f32x4 (&acc)[2][2][4][2], const Unit& u, int wr, int wc, int fr, int fq) const {
        const int row0 = u.pm * BM + wr * 64 + fr;
        const int col0 = u.pn * BM + wc * 32 + 8 * fq;
#pragma unroll
        for (int ai = 0; ai < 2; ++ai) {
            u32x4 bw[4][2];
#pragma unroll
            for (int m = 0; m < 4; ++m)
#pragma unroll
                for (int bj = 0; bj < 2; ++bj) bw[m][bj] = *(const u32x4*)(xb + (size_t)(row0 + ai * HALF + m * 16) * LDX + col0 + bj * HALF);
            __builtin_amdgcn_sched_barrier(0);
#pragma unroll
            for (int m = 0; m < 4; ++m) {
                const int row = row0 + ai * HALF + m * 16;
                const size_t off = (size_t)row * LDX + col0;
                float ss = 0.f;
#pragma unroll
                for (int bj = 0; bj < 2; ++bj) {
                    const f32x4 v0 = bf4_to_f32((unsigned long long)bw[m][bj].x | ((unsigned long long)bw[m][bj].y << 32)) + acc[ai][bj][m][0];
                    const f32x4 v1 = bf4_to_f32((unsigned long long)bw[m][bj].z | ((unsigned long long)bw[m][bj].w << 32)) + acc[ai][bj][m][1];
                    ss += (v0[0] * v0[0] + v0[1] * v0[1]) + (v0[2] * v0[2] + v0[3] * v0[3]) + (v1[0] * v1[0] + v1[1] * v1[1]) + (v1[2] * v1[2] + v1[3] * v1[3]);
                    u32x4 w; w.x = cvt_pk_bf16(v0[0], v0[1]); w.y = cvt_pk_bf16(v0[2], v0[3]); w.z = cvt_pk_bf16(v1[0], v1[1]); w.w = cvt_pk_bf16(v1[2], v1[3]);
                    *(u32x4*)(xb + off + bj * HALF) = w;
                }
                ss += __shfl_xor(ss, 16); ss += __shfl_xor(ss, 32);
                if (fq == 0) atomicAdd(ssq + row, (unsigned long long)(ss * 1048576.0f));
            }
        }
    }
};
struct EpiResidB2F {
    static constexpr bool PERM = true, AFTER_DRAIN = false;
    const bf16_t* xb; float* out;
    __device__ __forceinline__ void operator()(const f32x4 (&acc)[2][2][4][2], const Unit& u, int wr, int wc, int fr, int fq) const {
        const int row0 = u.pm * BM + wr * 64 + fr;
        const int col0 = u.pn * BM + wc * 32 + 8 * fq;
#pragma unroll
        for (int ai = 0; ai < 2; ++ai) {
            u32x4 bw[4][2];
#pragma unroll
            for (int m = 0; m < 4; ++m)
#pragma unroll
                for (int bj = 0; bj < 2; ++bj) bw[m][bj] = *(const u32x4*)(xb + (size_t)(row0 + ai * HALF + m * 16) * LDX + col0 + bj * HALF);
            __builtin_amdgcn_sched_barrier(0);
#pragma unroll
            for (int m = 0; m < 4; ++m) {
                const size_t off = (size_t)(row0 + ai * HALF + m * 16) * LDX + col0;
#pragma unroll
                for (int bj = 0; bj < 2; ++bj) {
                    *(f32x4*)(out + off + bj * HALF) = bf4_to_f32((unsigned long long)bw[m][bj].x | ((unsigned long long)bw[m][bj].y << 32)) + acc[ai][bj][m][0];
                    *(f32x4*)(out + off + bj * HALF + 4) = bf4_to_f32((unsigned long long)bw[m][bj].z | ((unsigned long long)bw[m][bj].w << 32)) + acc[ai][bj][m][1];
                }
            }
        }
    }
};
}
#define LAS __attribute__((address_space(3)))
typedef unsigned short bf16_t;
typedef short bf16x8 __attribute__((ext_vector_type(8)));
typedef short v4i16_t __attribute__((ext_vector_type(4)));
typedef float f32x2 __attribute__((ext_vector_type(2)));
typedef float f32x4 __attribute__((ext_vector_type(4)));
typedef float f32x16 __attribute__((ext_vector_type(16)));
typedef unsigned u32x2 __attribute__((ext_vector_type(2)));
typedef unsigned u32x4 __attribute__((ext_vector_type(4)));
typedef __bf16 bf16x2_t __attribute__((ext_vector_type(2)));

constexpr int BATCH = 2, SEQ = 4096, DM = 2048, DEPTH = 2, MROWS = BATCH * SEQ;
constexpr int NPROJ = 6144, DFF = 5632, NGU = 2 * DFF;
constexpr int LDP = NPROJ;
constexpr float NORM_EPS = 1e-6f;
constexpr int NTHREADS = 512, NWAVES = 8;

constexpr size_t MiB = 1u << 20;
constexpr size_t WS_CTL = 0;
constexpr size_t WS_TAB = 1 * MiB;
constexpr size_t WS_WIN = 4 * MiB;
constexpr size_t WS_WOUT = WS_WIN + 48 * MiB;
constexpr size_t WS_WGU = WS_WOUT + 16 * MiB;
constexpr size_t WS_WDN = WS_WGU + 88 * MiB;
constexpr size_t WS_XN = WS_WDN + 44 * MiB;
constexpr size_t WS_PROJ = WS_XN + 32 * MiB;
constexpr size_t WS_MIX = WS_PROJ + 96 * MiB;
constexpr size_t WS_DIFFO = WS_MIX + 32 * MiB;
constexpr size_t WS_ML = WS_DIFFO + 64 * MiB;
constexpr size_t WS_DILP2 = WS_ML + 1 * MiB;
constexpr size_t WS_DLSE = WS_DILP2 + 16 * MiB;
constexpr size_t WS_END = WS_DLSE + 1 * MiB;

constexpr int LDS_RING = 131072, LDS_BYTES = LDS_RING + 256;

__constant__ float INVF[24] = {
    1.000000000e+00f, 1.939227432e-01f, 3.760603070e-02f, 7.292664610e-03f, 1.414213562e-03f, 2.742481884e-04f, 5.318295734e-05f, 1.031338525e-05f,
    1.000000000e+00f, 4.403665960e-01f, 1.939227432e-01f, 8.539710194e-02f, 3.760603070e-02f, 1.656044088e-02f, 7.292664610e-03f, 3.211446106e-03f,
    1.414213562e-03f, 6.227724371e-04f, 2.742481884e-04f, 1.207697351e-04f, 5.318295734e-05f, 2.341999971e-05f, 1.031338525e-05f, 4.541670478e-06f};


constexpr int Q_NSEG = 18, Q_TOTAL = 1280;
__constant__ int QSEG_START[Q_NSEG] = {0, 32, 48, 80, 96, 128, 160, 176, 208, 240, 256, 288, 320, 336, 352, 480, 1248, 1264};
__constant__ int QSEG_KIND[Q_NSEG]  = {3, 1, 3, 1, 3, 3, 1, 3, 3, 1, 3, 3, 1, 1, 0, 2, 1, 1};
__constant__ int QSEG_QB[Q_NSEG]    = {15, 7, 14, 6, 13, 12, 5, 11, 10, 4, 9, 8, 3, 2, 0, 0, 1, 0};

__device__ __forceinline__ unsigned f2bf(float f) { unsigned u = __builtin_bit_cast(unsigned, f); return (u + 0x7fffu + ((u >> 16) & 1u)) >> 16; }
__device__ __forceinline__ unsigned pk2(float lo, float hi) { return f2bf(lo) | (f2bf(hi) << 16); }
__device__ __forceinline__ unsigned cvtpk(float lo, float hi) { f32x2 v = {lo, hi}; bf16x2_t b = __builtin_convertvector(v, bf16x2_t); return __builtin_bit_cast(unsigned, b); }
__device__ __forceinline__ float wave_sum(float v) {
#pragma unroll
    for (int o = 1; o < 64; o <<= 1) v += __shfl_xor(v, o);
    return v;
}
__device__ __forceinline__ int crow(int r, int hi) { return (r & 3) + 8 * (r >> 2) + 4 * hi; }
#define LDS_WAIT() asm volatile("s_waitcnt lgkmcnt(0)" ::: "memory")
#define CFENCE() asm volatile("" ::: "memory")

__device__ __forceinline__ void sincos_acc(float x, float& s, float& c) {
    const double xd = (double)x;
    const double kd = __builtin_rint(xd * 0.63661977236758134308);
    double r = __builtin_fma(-kd, 1.57079632679489655800e+00, xd);
    r = __builtin_fma(-kd, 6.12323399573676603587e-17, r);
    const long long k = (long long)kd;
    const double r2 = r * r;
    const double sp = r * (1.0 + r2 * (-1.0 / 6.0 + r2 * (1.0 / 120.0 + r2 * (-1.0 / 5040.0 + r2 * (1.0 / 362880.0 + r2 * (-1.0 / 39916800.0 + r2 * (1.0 / 6227020800.0)))))));
    const double cp = 1.0 + r2 * (-0.5 + r2 * (1.0 / 24.0 + r2 * (-1.0 / 720.0 + r2 * (1.0 / 40320.0 + r2 * (-1.0 / 3628800.0 + r2 * (1.0 / 479001600.0 + r2 * (-1.0 / 87178291200.0)))))));
    const int qd = (int)(k & 3);
    const double sv = (qd == 0) ? sp : (qd == 1) ? cp : (qd == 2) ? -sp : -cp;
    const double cv = (qd == 0) ? cp : (qd == 1) ? -sp : (qd == 2) ? -cp : sp;
    s = (float)sv; c = (float)cv;
}

__device__ __forceinline__ void tr_item(const float* __restrict__ W, int K, int N, int sc0, int permkind, bf16_t* __restrict__ WT, int dr0, int k0, LAS float* scr, int lane, const float* __restrict__ gk = nullptr) {
    const int j = lane & 31; int pj = j;
    if (permkind == 1) { if (j < 16) pj = (j >> 1) + 8 * (j & 1); }
    else if (permkind == 2) pj = (j >> 1) + 16 * (j & 1);
    const float* src = W + (size_t)k0 * N + sc0 + pj;
    float tv[32];
#pragma unroll
    for (int i = 0; i < 32; ++i) tv[i] = src[(size_t)(2 * i + (lane >> 5)) * N];
    if (gk) {
#pragma unroll
        for (int i = 0; i < 32; ++i) tv[i] *= gk[k0 + 2 * i + (lane >> 5)];
    }
#pragma unroll
    for (int i = 0; i < 32; ++i) scr[(2 * i + (lane >> 5)) * 33 + j] = tv[i];
    LDS_WAIT();
    const int c = lane & 7;
#pragma unroll
    for (int jj = 0; jj < 4; ++jj) { const int n = (lane >> 3) + 8 * jj; const LAS float* s = scr + (8 * c) * 33 + n;
        u32x4 o; o.x = pk2(s[0 * 33], s[1 * 33]); o.y = pk2(s[2 * 33], s[3 * 33]); o.z = pk2(s[4 * 33], s[5 * 33]); o.w = pk2(s[6 * 33], s[7 * 33]);
        *(u32x4*)(WT + (size_t)(dr0 + n) * K + k0 + 8 * c) = o; }
    LDS_WAIT();
}

struct TrDesc { const float* src; bf16_t* dst; const float* gk; int N, K, k0, pk; bool valid; };
__device__ __forceinline__ void tr_load(const TrDesc& t, int lane, float (&tv)[32]) {
    const int j = lane & 31; int pj = j;
    if (t.pk == 1) { if (j < 16) pj = (j >> 1) + 8 * (j & 1); }
    else if (t.pk == 2) pj = (j >> 1) + 16 * (j & 1);
    const float* src = t.src + pj;
#pragma unroll
    for (int i = 0; i < 32; ++i) tv[i] = src[(size_t)(2 * i + (lane >> 5)) * t.N];
}
__device__ __forceinline__ void tr_finish(const TrDesc& t, float (&tv)[32], LAS float* scr, int lane) {
    const int j = lane & 31;
    if (t.gk) {
#pragma unroll
        for (int i = 0; i < 32; ++i) tv[i] *= t.gk[t.k0 + 2 * i + (lane >> 5)];
    }
#pragma unroll
    for (int i = 0; i < 32; ++i) scr[(2 * i + (lane >> 5)) * 33 + j] = tv[i];
    LDS_WAIT();
    const int c = lane & 7;
#pragma unroll
    for (int jj = 0; jj < 4; ++jj) { const int n = (lane >> 3) + 8 * jj; const LAS float* s = scr + (8 * c) * 33 + n;
        u32x4 o; o.x = pk2(s[0 * 33], s[1 * 33]); o.y = pk2(s[2 * 33], s[3 * 33]); o.z = pk2(s[4 * 33], s[5 * 33]); o.w = pk2(s[6 * 33], s[7 * 33]);
        *(u32x4*)(t.dst + (size_t)n * t.K + 8 * c) = o; }
    LDS_WAIT();
}
__device__ __forceinline__ void xb_rows(const float* src, bf16_t* dst, unsigned long long* ssq, int gw, int ngw, int lane) {
    for (int m = gw; m < MROWS; m += ngw) {
        const f32x4* xr = (const f32x4*)(src + (size_t)m * DM) + lane;
        f32x4 v[8]; float ss = 0.f;
#pragma unroll
        for (int j = 0; j < 8; ++j) { v[j] = xr[64 * j]; ss += (v[j].x * v[j].x + v[j].y * v[j].y) + (v[j].z * v[j].z + v[j].w * v[j].w); }
        ss = wave_sum(ss);
        if (lane == 0) ssq[m] = (unsigned long long)(ss * 1048576.0f);
        u32x2* o8 = (u32x2*)(dst + (size_t)m * DM) + lane;
#pragma unroll
        for (int j = 0; j < 8; ++j) { u32x2 w; w.x = pk2(v[j].x, v[j].y); w.y = pk2(v[j].z, v[j].w); o8[64 * j] = w; }
    }
}
__device__ __forceinline__ void rms_rows_bf16(const float* src, const float* __restrict__ g, bf16_t* dst, int gw, int ngw, int lane) {
    for (int m = gw; m < MROWS; m += ngw) {
        const f32x4* xr = (const f32x4*)(src + (size_t)m * DM) + lane;
        f32x4 v[8]; float ss = 0.f;
#pragma unroll
        for (int j = 0; j < 8; ++j) { v[j] = xr[64 * j]; ss += (v[j].x * v[j].x + v[j].y * v[j].y) + (v[j].z * v[j].z + v[j].w * v[j].w); }
        const float rstd = 1.0f / sqrtf(wave_sum(ss) * (1.0f / DM) + NORM_EPS);
        u32x2* o8 = (u32x2*)(dst + (size_t)m * DM) + lane;
#pragma unroll
        for (int j = 0; j < 8; ++j) { const f32x4 gv = ((const f32x4*)g)[lane + 64 * j]; const f32x4 y = v[j] * rstd * gv;
            u32x2 w; w.x = pk2(y.x, y.y); w.y = pk2(y.z, y.w); o8[64 * j] = w; }
    }
}
__device__ __forceinline__ void rms_rows_f32_inplace(float* buf, const float* __restrict__ g, int gw, int ngw, int lane) {
    for (int m = gw; m < MROWS; m += ngw) {
        f32x4* xr = (f32x4*)(buf + (size_t)m * DM) + lane;
        f32x4 v[8]; float ss = 0.f;
#pragma unroll
        for (int j = 0; j < 8; ++j) { v[j] = xr[64 * j]; ss += (v[j].x * v[j].x + v[j].y * v[j].y) + (v[j].z * v[j].z + v[j].w * v[j].w); }
        const float rstd = 1.0f / sqrtf(wave_sum(ss) * (1.0f / DM) + NORM_EPS);
#pragma unroll
        for (int j = 0; j < 8; ++j) { const f32x4 gv = ((const f32x4*)g)[lane + 64 * j]; xr[64 * j] = v[j] * rstd * gv; }
    }
}

constexpr int VRS = 320;
#define SCHED_FENCE() __builtin_amdgcn_sched_barrier(0)
__device__ __forceinline__ float xhalf_max(float x) { auto rr = __builtin_amdgcn_permlane32_swap(__float_as_uint(x), __float_as_uint(x), false, false); return fmaxf(__uint_as_float(rr[0]), __uint_as_float(rr[1])); }
__device__ __forceinline__ float xhalf_sum(float x) { auto rr = __builtin_amdgcn_permlane32_swap(__float_as_uint(x), __float_as_uint(x), false, false); return __uint_as_float(rr[0]) + __uint_as_float(rr[1]); }
template <int NDS>
__device__ __forceinline__ f32x16 qk_lds(LAS const unsigned char* kl  , const bf16x8 (&qf)[NDS]) {
    bf16x8 kf[NDS];
#pragma unroll
    for (int ds = 0; ds < NDS; ++ds) kf[ds] = *(LAS const bf16x8*)(kl + 32 * ds);
    SCHED_FENCE();
    f32x16 s = {};
    __builtin_amdgcn_s_setprio(1);
#pragma unroll
    for (int ds = 0; ds < NDS; ++ds) s = __builtin_amdgcn_mfma_f32_32x32x16_bf16(kf[ds], qf[ds], s, 0, 0, 0);
    __builtin_amdgcn_s_setprio(0);
    return s;
}
__device__ __forceinline__ bf16x8 pack8(const f32x16& p, int b) {
    u32x4 w; w.x = cvtpk(p[b + 0], p[b + 1]); w.y = cvtpk(p[b + 2], p[b + 3]); w.z = cvtpk(p[b + 4], p[b + 5]); w.w = cvtpk(p[b + 6], p[b + 7]);
    return __builtin_bit_cast(bf16x8, w);
}
__device__ __forceinline__ v4i16_t vtr(LAS const unsigned char* p) { return __builtin_amdgcn_ds_read_tr16_b64_v4i16((LAS v4i16_t*)p); }
struct VFrag { v4i16_t a0, a1, b0, b1; };
__device__ __forceinline__ VFrag vfrag_read(LAS const unsigned char* vlane, int db) {
    VFrag f; f.a0 = vtr(vlane + db * 64); f.a1 = vtr(vlane + db * 64 + 8 * VRS); f.b0 = vtr(vlane + db * 64 + 16 * VRS); f.b1 = vtr(vlane + db * 64 + 24 * VRS); return f;
}
__device__ __forceinline__ void pv_accum(f32x16 (&o)[4], LAS const unsigned char* vlane, const f32x16& p, VFrag f) {
    const bf16x8 pb0 = pack8(p, 0), pb1 = pack8(p, 8);
    __builtin_amdgcn_s_setprio(1);
#pragma unroll
    for (int db = 0; db < 4; ++db) {
        VFrag n = f;
        if (db < 3) n = vfrag_read(vlane, db + 1);
        SCHED_FENCE();
        const bf16x8 v0 = (bf16x8){f.a0[0], f.a0[1], f.a0[2], f.a0[3], f.a1[0], f.a1[1], f.a1[2], f.a1[3]};
        const bf16x8 v1 = (bf16x8){f.b0[0], f.b0[1], f.b0[2], f.b0[3], f.b1[0], f.b1[1], f.b1[2], f.b1[3]};
        o[db] = __builtin_amdgcn_mfma_f32_32x32x16_bf16(v0, pb0, o[db], 0, 0, 0);
        o[db] = __builtin_amdgcn_mfma_f32_32x32x16_bf16(v1, pb1, o[db], 0, 0, 0);
        SCHED_FENCE();
        f = n;
    }
    __builtin_amdgcn_s_setprio(0);
}
constexpr float SM_THR = 8.0f;
__device__ __forceinline__ float fadd_s(float a, float b) { float r = a + b; asm("" : "+v"(r)); return r; }
__device__ __forceinline__ void softmax_step(f32x16& s, float& m, float& lsum, f32x16 (&o)[4]) {
    float mx = s[0];
#pragma unroll
    for (int r = 1; r < 16; ++r) mx = fmaxf(mx, s[r]);
    mx = xhalf_max(mx);
    if (__any(mx > m + SM_THR)) {
        const float mnew = fmaxf(m, mx); const float alpha = __builtin_amdgcn_exp2f(m - mnew); m = mnew;
        lsum *= alpha;
#pragma unroll
        for (int db = 0; db < 4; ++db) o[db] = o[db] * alpha;
    }
    float ps = 0.f;
#pragma unroll
    for (int r = 0; r < 16; ++r) { s[r] = __builtin_amdgcn_exp2f(s[r] - m); ps = fadd_s(ps, s[r]); }
    lsum += ps;
}
constexpr int OST_RS = 272, OST_WAVE = 32 * OST_RS;
__device__ __forceinline__ void stage_store_bf16(LAS unsigned char* stg, const f32x16 (&o)[4], float sc, const float* __restrict__ g, int lane, bf16_t* dst0, size_t rs) {
    const int q = lane & 31, h = lane >> 5;
#pragma unroll
    for (int db = 0; db < 4; ++db)
#pragma unroll
        for (int a = 0; a < 4; ++a) { const int d0 = 32 * db + 8 * a + 4 * h; f32x4 gv = (f32x4){1.f, 1.f, 1.f, 1.f}; if (g) gv = *(const f32x4*)(g + d0);
            u32x2 w; w.x = cvtpk(o[db][4 * a + 0] * sc * gv.x, o[db][4 * a + 1] * sc * gv.y); w.y = cvtpk(o[db][4 * a + 2] * sc * gv.z, o[db][4 * a + 3] * sc * gv.w);
            *(LAS u32x2*)(stg + q * OST_RS + 2 * d0) = w; }
    CFENCE();
#pragma unroll
    for (int i = 0; i < 8; ++i) { const int row = 4 * i + (lane >> 4), ch = lane & 15;
        const u32x4 v = *(LAS const u32x4*)(stg + row * OST_RS + 16 * ch);
        *(u32x4*)(dst0 + (size_t)row * rs + 8 * ch) = v; }
    CFENCE();
}
__device__ __forceinline__ void stage_store_f32(LAS unsigned char* stg, const f32x16 (&o)[4], int lane, float* dst0, size_t rs) {
    const int q = lane & 31, h = lane >> 5;
#pragma unroll
    for (int hf = 0; hf < 2; ++hf) {
#pragma unroll
        for (int dd = 0; dd < 2; ++dd)
#pragma unroll
            for (int a = 0; a < 4; ++a) { const int d0 = 32 * dd + 8 * a + 4 * h;
                *(LAS f32x4*)(stg + q * OST_RS + 4 * d0) = (f32x4){o[2 * hf + dd][4 * a], o[2 * hf + dd][4 * a + 1], o[2 * hf + dd][4 * a + 2], o[2 * hf + dd][4 * a + 3]}; }
        CFENCE();
#pragma unroll
        for (int i = 0; i < 8; ++i) { const int row = 4 * i + (lane >> 4), ch = lane & 15;
            const f32x4 v = *(LAS const f32x4*)(stg + row * OST_RS + 16 * ch);
            *(f32x4*)(dst0 + (size_t)row * rs + 64 * hf + 4 * ch) = v; }
        CFENCE();
    }
}
__device__ __forceinline__ float head_norm_scale(const f32x16 (&o)[4]) {
    float ss = 0.f;
#pragma unroll
    for (int db = 0; db < 4; ++db)
#pragma unroll
        for (int r = 0; r < 16; ++r) ss += o[db][r] * o[db][r];
    ss = xhalf_sum(ss);
    return 1.0f / sqrtf(ss * (1.0f / 128.0f) + NORM_EPS);
}
__device__ __forceinline__ void head_norm_store(bf16_t* dst, const f32x16 (&o)[4], float pre, const float* __restrict__ g, float mult, int h) {
    float ss = 0.f;
#pragma unroll
    for (int db = 0; db < 4; ++db)
#pragma unroll
        for (int r = 0; r < 16; ++r) { const float v = o[db][r] * pre; ss += v * v; }
    ss += __shfl_xor(ss, 32);
    const float sc = pre * mult / sqrtf(ss * (1.0f / 128.0f) + NORM_EPS);
#pragma unroll
    for (int db = 0; db < 4; ++db)
#pragma unroll
        for (int a = 0; a < 4; ++a) { const int d0 = 32 * db + 8 * a + 4 * h; const f32x4 gv = *(const f32x4*)(g + d0);
            u32x2 w; w.x = cvtpk(o[db][4 * a + 0] * sc * gv.x, o[db][4 * a + 1] * sc * gv.y); w.y = cvtpk(o[db][4 * a + 2] * sc * gv.z, o[db][4 * a + 3] * sc * gv.w);
            *(u32x2*)(dst + d0) = w; }
}

#define LDS_BAR() do { asm volatile("s_waitcnt lgkmcnt(0)" ::: "memory"); __builtin_amdgcn_s_barrier(); asm volatile("" ::: "memory"); } while (0)
struct PFrag { bf16x8 a0, a1, b0, b1; };
template <int NDS, int KRS>
__device__ __forceinline__ void qk_sm64(LAS const unsigned char* kl, const bf16x8 (&qf)[NDS], f32x16 (&o)[4], float& m, float& lsum, PFrag& P) {
    SCHED_FENCE();
    bf16x8 kA[NDS];
#pragma unroll
    for (int ds = 0; ds < NDS; ++ds) kA[ds] = *(LAS const bf16x8*)(kl + 32 * ds);
    SCHED_FENCE();
    f32x16 s0 = {}, s1 = {};
    bf16x8 kB[NDS];
#pragma unroll
    for (int ds = 0; ds < NDS; ++ds) kB[ds] = *(LAS const bf16x8*)(kl + 32 * KRS + 32 * ds);
    __builtin_amdgcn_s_setprio(1);
#pragma unroll
    for (int ds = 0; ds < NDS; ++ds) s0 = __builtin_amdgcn_mfma_f32_32x32x16_bf16(kA[ds], qf[ds], s0, 0, 0, 0);
    SCHED_FENCE();
#pragma unroll
    for (int ds = 0; ds < NDS; ++ds) s1 = __builtin_amdgcn_mfma_f32_32x32x16_bf16(kB[ds], qf[ds], s1, 0, 0, 0);
    __builtin_amdgcn_s_setprio(0);
    float mx = fmaxf(s0[0], s1[0]);
#pragma unroll
    for (int r = 1; r < 16; ++r) mx = fmaxf(fmaxf(mx, s0[r]), s1[r]);
    mx = xhalf_max(mx);
    if (__any(mx > m + SM_THR)) {
        const float mnew = fmaxf(m, mx); const float alpha = __builtin_amdgcn_exp2f(m - mnew); m = mnew;
        lsum *= alpha;
#pragma unroll
        for (int db = 0; db < 4; ++db) o[db] = o[db] * alpha;
    }
    float psa = 0.f, psb = 0.f;
#pragma unroll
    for (int r = 0; r < 16; ++r) { s0[r] = __builtin_amdgcn_exp2f(s0[r] - m); s1[r] = __builtin_amdgcn_exp2f(s1[r] - m); psa = fadd_s(psa, s0[r]); psb = fadd_s(psb, s1[r]); }
    lsum += psa + psb;
    P.a0 = pack8(s0, 0); P.a1 = pack8(s0, 8); P.b0 = pack8(s1, 0); P.b1 = pack8(s1, 8);
}
template <bool PRE>
__device__ __forceinline__ void pv64(LAS const unsigned char* vl, const PFrag& P, f32x16 (&o)[4]) {
    VFrag f = vfrag_read(vl, 0);
    __builtin_amdgcn_s_setprio(1);
#pragma unroll
    for (int blk = 0; blk < 8; ++blk) {
        const int db = blk >> 1, sub = blk & 1;
        VFrag n = f;
        if (PRE && blk < 7) n = vfrag_read(vl + ((blk + 1) & 1) * 32 * VRS, (blk + 1) >> 1);
        SCHED_FENCE();
        const bf16x8 v0 = (bf16x8){f.a0[0], f.a0[1], f.a0[2], f.a0[3], f.a1[0], f.a1[1], f.a1[2], f.a1[3]};
        const bf16x8 v1 = (bf16x8){f.b0[0], f.b0[1], f.b0[2], f.b0[3], f.b1[0], f.b1[1], f.b1[2], f.b1[3]};
        o[db] = __builtin_amdgcn_mfma_f32_32x32x16_bf16(v0, sub ? P.b0 : P.a0, o[db], 0, 0, 0);
        o[db] = __builtin_amdgcn_mfma_f32_32x32x16_bf16(v1, sub ? P.b1 : P.a1, o[db], 0, 0, 0);
        SCHED_FENCE();
        if (!PRE && blk < 7) n = vfrag_read(vl + ((blk + 1) & 1) * 32 * VRS, (blk + 1) >> 1);
        f = n;
    }
    __builtin_amdgcn_s_setprio(0);
}

template <int MODE, int NDS, int KRS>
__device__ __forceinline__ void cu_tile(LAS const unsigned char* ktile, LAS const unsigned char* vtile, int kv0, int qw0, int qpos, int q, int h, int klane_off, int vlane_off, bool wdone,
                                        const bf16x8 (&qf)[NDS], const bf16x8& T0, const bf16x8& T1, f32x16 (&o)[4], float& m, float& lsum, float& carry) {
#pragma unroll
    for (int sub = 1; sub >= 0; --sub) {
        const int kvs0 = kv0 + 32 * sub;
        if (kvs0 <= qw0 && !wdone && (MODE != 2 || kvs0 >= qw0 - 128)) {
            const bool diag = (kvs0 == qw0);
            LAS const unsigned char* kl = ktile + 32 * sub * KRS + klane_off;
            LAS const unsigned char* vl = vtile + 32 * sub * VRS + vlane_off;
            f32x16 s = qk_lds<NDS>(kl, qf);
            const VFrag vf0 = vfrag_read(vl, 0);
            SCHED_FENCE();
            if (MODE != 0) {
                if (diag) {
#pragma unroll
                    for (int r = 0; r < 16; ++r) if (kvs0 + crow(r, h) > qpos) s[r] = -INFINITY;
                }
                if (MODE == 2 && kvs0 == qw0 - 128) {
#pragma unroll
                    for (int r = 0; r < 16; ++r) if (crow(r, h) < q) s[r] = -INFINITY;
                }
                softmax_step(s, m, lsum, o);
            } else {
                f32x16 sp;
                float tot = 0.f;
#pragma unroll
                for (int r = 0; r < 16; ++r) {
                    const float z = s[r];
                    const float e = __builtin_amdgcn_exp2f(-fabsf(z));
                    float v = fmaxf(z, 0.f) + __builtin_amdgcn_logf(1.0f + e);
                    if (diag && !(kvs0 + crow(r, h) < qpos)) v = 0.f;
                    sp[r] = v; tot += v;
                }
                tot = xhalf_sum(tot);
                const bf16x8 spb0 = pack8(sp, 0), spb1 = pack8(sp, 8);
#pragma unroll
                for (int r = 0; r < 16; ++r) s[r] = s[r] - sp[r] - carry;
                f32x16 w = {};
                w = __builtin_amdgcn_mfma_f32_32x32x16_bf16(T0, spb0, w, 0, 0, 0);
                w = __builtin_amdgcn_mfma_f32_32x32x16_bf16(T1, spb1, w, 0, 0, 0);
#pragma unroll
                for (int r = 0; r < 16; ++r) {
                    float a = __builtin_amdgcn_exp2f(s[r] - w[r]);
                    if (diag && !(kvs0 + crow(r, h) < qpos)) a = 0.f;
                    s[r] = a;
                }
                carry += tot;
            }
            pv_accum(o, vl, s, vf0);
        }
    }
}

template <int MODE>
__device__ __forceinline__ void causal_unit(const bf16_t* __restrict__ P, int b, int qb, int qcol, int kcol, int vcol, LAS unsigned char* lds, int tid, int wid, int lane,
                                            int t_lo, int t_hi, int cls, int stride, volatile LAS unsigned* vote, f32x16 (&o)[4], float& lsum_out, float& m_out) {
    constexpr int DQK = MODE == 1 ? 64 : 128, NDS = DQK / 16, KRS = DQK * 2 + 16, KBUF = 64 * KRS, VBUF = 64 * VRS, CPRK = DQK / 8, NKL = (64 * CPRK) / NTHREADS;
    const int q = lane & 31, h = lane >> 5;
    const size_t rb = (size_t)b * SEQ + cls;
    const int q0 = qb * 256, qw0 = q0 + 32 * wid, qpos = qw0 + q;
    bf16x8 qf[NDS];
#pragma unroll
    for (int ds = 0; ds < NDS; ++ds) qf[ds] = *(const bf16x8*)(P + (rb + (size_t)stride * qpos) * LDP + qcol + 16 * ds + 8 * h);
#pragma unroll
    for (int db = 0; db < 4; ++db) o[db] = (f32x16){};
    float m = -1e30f, lsum = 0.f, carry = 0.f;
    bf16x8 T0, T1;
#pragma unroll
    for (int j = 0; j < 8; ++j) { const int kv = 8 * (j >> 2) + 4 * h + (j & 3); T0[j] = (kv > q) ? (short)0x3F80 : (short)0; T1[j] = (16 + kv > q) ? (short)0x3F80 : (short)0; }
    const int NT = t_hi - t_lo;
    static_assert(NKL == 1 || CPRK == 16, "second K piece = +32 rows");
    const int kgo = stride * (tid / CPRK) * LDP + kcol + 8 * (tid % CPRK), klo = (tid / CPRK) * KRS + 16 * (tid % CPRK);
    const int vgo = stride * (tid >> 4) * LDP + vcol + 8 * (tid & 15), vlo = 3 * KBUF + (tid >> 4) * VRS + 16 * (tid & 15);
#define CU_GLOAD(kr, vr, t) do { const bf16_t* p0_ = P + (rb + (size_t)stride * 64 * (size_t)(t)) * LDP; \
        _Pragma("unroll") for (int i = 0; i < NKL; ++i) kr[i] = *(const u32x4*)(p0_ + kgo + i * 32 * stride * LDP); \
        _Pragma("unroll") for (int i = 0; i < 2; ++i) vr[i] = *(const u32x4*)(p0_ + vgo + i * 32 * stride * LDP); } while (0)
#define CU_LSTORE(kr, vr, buf) do { \
        _Pragma("unroll") for (int i = 0; i < NKL; ++i) *(LAS u32x4*)(lds + (buf) * KBUF + klo + i * 32 * KRS) = kr[i]; \
        _Pragma("unroll") for (int i = 0; i < 2; ++i) *(LAS u32x4*)(lds + (buf) * VBUF + vlo + i * 32 * VRS) = vr[i]; } while (0)
    const int g16 = lane >> 4, i16 = lane & 15;
    const int vlane_off = (4 * h + (i16 >> 2)) * VRS + (16 * (g16 & 1) + 4 * (i16 & 3)) * 2;
    const int klane_off = q * KRS + 16 * h;
    u32x4 krA[NKL], vrA[2], krB[NKL], vrB[2];
    CU_GLOAD(krA, vrA, t_hi - 1); CU_LSTORE(krA, vrA, 0);
    __builtin_amdgcn_s_waitcnt(0x0F70);
#define CU_TCL(t) ((t) < t_lo ? t_lo : (t))
    CU_GLOAD(krA, vrA, CU_TCL(t_hi - 2));
    CU_GLOAD(krB, vrB, CU_TCL(t_hi - 3));
    LDS_BAR();
    bool wdone = false;
#define CU_END_STEP(slot) do { \
        if (MODE == 0) { wdone = __all(carry > 150.0f) != 0; if (lane == 0) vote[(slot) * 8 + wid] = wdone ? 1u : 0u; } \
        LDS_BAR(); \
        if (MODE == 0) { const u32x4 f0 = *(volatile LAS u32x4*)(vote + (slot) * 8), f1 = *(volatile LAS u32x4*)(vote + (slot) * 8 + 4); \
            alldone = (f0.x & f0.y & f0.z & f0.w & f1.x & f1.y & f1.z & f1.w) != 0u; } } while (0)
    bool alldone = false;
    const bool late = (wid >= 4);
    const int n_gen = (MODE == 1) ? ((64 * t_hi > q0) ? 4 : 0) : NT;
    int bi = 0;
#define CU_STEP(WHO, KR, VR, itx, DIST) do { const int bn_ = (bi == 2) ? 0 : bi + 1; \
        LAS const unsigned char* kt_ = lds + bi * KBUF; LAS const unsigned char* vt_ = lds + 3 * KBUF + bi * VBUF; \
        if ((WHO) == 0) cu_tile<MODE, NDS, KRS>(kt_, vt_, 64 * (t_hi - 1 - (itx)), qw0, qpos, q, h, klane_off, vlane_off, wdone, qf, T0, T1, o, m, lsum, carry); \
        else if ((WHO) == 1) { PFrag P_; qk_sm64<NDS, KRS>(kt_ + klane_off, qf, o, m, lsum, P_); pv64<true>(vt_ + vlane_off, P_, o); } \
        else { pv64<false>(vprev, Pp, o); qk_sm64<NDS, KRS>(kt_ + klane_off, qf, o, m, lsum, Pp); vprev = vt_ + vlane_off; } \
        CU_LSTORE(KR, VR, bn_); CU_GLOAD(KR, VR, CU_TCL(t_hi - 1 - (itx) - (DIST))); \
        CU_END_STEP((itx) & 1); bi = bn_; } while (0)
    PFrag Pp; Pp.a0 = (bf16x8){}; Pp.a1 = (bf16x8){}; Pp.b0 = (bf16x8){}; Pp.b1 = (bf16x8){};
    LAS const unsigned char* vprev = lds + 3 * KBUF + vlane_off;
    int it = 0;
    for (; it < n_gen; it += 2) {
        CU_STEP(0, krA, vrA, it, 3);
        if (it + 1 >= NT || alldone) break;
        CU_STEP(0, krB, vrB, it + 1, 3);
        if (alldone) break;
    }
    if (MODE == 1) {
        if (!late) {
            for (; it < NT; it += 2) {
                CU_STEP(1, krA, vrA, it, 2);
                if (it + 1 >= NT) break;
                CU_STEP(1, krA, vrA, it + 1, 2);
            }
        } else {
            for (; it < NT; it += 2) {
                CU_STEP(2, krA, vrA, it, 2);
                if (it + 1 >= NT) break;
                CU_STEP(2, krA, vrA, it + 1, 2);
            }
            pv64<false>(vprev, Pp, o);
        }
        LDS_BAR();
    }
#undef CU_STEP
#undef CU_TCL
#undef CU_END_STEP
#undef CU_GLOAD
#undef CU_LSTORE
    lsum_out = xhalf_sum(lsum); m_out = m;
}

#define XB_TMO      128
#define XB_XCNT(j)  (256  + 64 * (j))
#define XB_XSUB(j)  (1280 + 64 * (j))
#define XB_XGEN(j)  (2304 + 64 * (j))
#define XB_TOP      3328
#define XB_TOPGEN   3392
#define XCD_BAR_WORDS 3456
#define XB_SPIN_CAP (1u << 18)

__device__ __forceinline__ unsigned xb_ld(unsigned* p)              { return __hip_atomic_load(p, __ATOMIC_RELAXED, __HIP_MEMORY_SCOPE_AGENT); }
__device__ __forceinline__ unsigned xb_add(unsigned* p, unsigned v) { return __hip_atomic_fetch_add(p, v, __ATOMIC_RELAXED, __HIP_MEMORY_SCOPE_AGENT); }
__device__ __forceinline__ unsigned xb_xcc_id() { return (unsigned)__builtin_amdgcn_s_getreg((3 << 11) | 20) & 0xFu; }
#define XB_SPIN(cond, bar) do { unsigned _sp = 0; while (cond) { __builtin_amdgcn_s_sleep(1); \
    if ((++_sp & 255u) == 0u) { if (xb_ld(&(bar)[XB_TMO])) break; if (_sp > XB_SPIN_CAP) { atomicAdd(&(bar)[XB_TMO], 1u); break; } } } } while (0)

struct XcdBarrier {
    unsigned* bar; unsigned x;
    volatile LAS unsigned* st;
};

__device__ __forceinline__ XcdBarrier xcd_barrier_post(unsigned* bar, volatile LAS unsigned* st) {
    XcdBarrier b; b.bar = bar; b.x = xb_xcc_id(); b.st = st;
    if (threadIdx.x == 0) (void)xb_add(&bar[XB_XCNT(b.x)], 1u);
    return b;
}
__device__ __forceinline__ void xcd_barrier_complete(unsigned* bar, unsigned x, unsigned& nloc, unsigned& nx) {
    const unsigned G = gridDim.x * gridDim.y * gridDim.z;
    unsigned sum, cnt, mine, sp = 0u;
    for (;;) {
        sum = 0u; cnt = 0u; mine = 0u;
#pragma unroll
        for (unsigned j = 0; j < 16; ++j) { const unsigned c = xb_ld(&bar[XB_XCNT(j)]); sum += c; cnt += (c > 0u) ? 1u : 0u; mine = (j == x) ? c : mine; }
        if (sum == G) break;
        __builtin_amdgcn_s_sleep(1);
        if ((++sp & 255u) == 0u) { if (xb_ld(&bar[XB_TMO])) break; if (sp > XB_SPIN_CAP) { atomicAdd(&bar[XB_TMO], 1u); break; } }
    }
    nloc = mine > 0u ? mine : 1u; nx = cnt > 0u ? cnt : 1u;
}

__device__ __forceinline__ void xcd_barrier(const XcdBarrier& b) {
    asm volatile("s_waitcnt vmcnt(0)" ::: "memory");
    __syncthreads();
    if (threadIdx.x == 0) {
        unsigned* bar = b.bar;
        __builtin_amdgcn_s_waitcnt(0);
        unsigned nloc = b.st[0], nx = b.st[1];
        if (nloc == 0u) { xcd_barrier_complete(bar, b.x, nloc, nx); b.st[0] = nloc; b.st[1] = nx; }
        const unsigned old = xb_add(&bar[XB_XSUB(b.x)], 1u);
        const unsigned gen = old / nloc;
        if (old + 1u == (gen + 1u) * nloc) {
            __builtin_amdgcn_fence(__ATOMIC_RELEASE, "agent");
            asm volatile("s_waitcnt vmcnt(0)" ::: "memory");
            const unsigned og = xb_add(&bar[XB_TOP], 1u);
            const unsigned tg = og / nx;
            if (og + 1u == (tg + 1u) * nx) xb_add(&bar[XB_TOPGEN], 1u);
            else XB_SPIN(xb_ld(&bar[XB_TOPGEN]) == tg, bar);
            __builtin_amdgcn_fence(__ATOMIC_ACQUIRE, "agent");
            xb_add(&bar[XB_XGEN(b.x)], 1u);
            asm volatile("s_waitcnt vmcnt(0)" ::: "memory");
        } else {
            XB_SPIN(xb_ld(&bar[XB_XGEN(b.x)]) == gen, bar);
            __builtin_amdgcn_fence(__ATOMIC_ACQUIRE, "agent");
            asm volatile("s_waitcnt vmcnt(0)" ::: "memory");
        }
    }
    __syncthreads();
}

struct Args {
    const float* x; const int* pos; const float* norm_mix_g; const float* w_in; const float* lq1; const float* lk1; const float* lq2; const float* lk2;
    const float* g_sb; const float* g_diff; const float* g_dil; const float* w_out; const float* norm_ffn_g; const float* w_gate; const float* w_up; const float* w_down;
    const float* norm_final_g; float* out; unsigned char* ws;
};

__global__ void __launch_bounds__(NTHREADS, 2) mega_fwd(Args a) {
    extern __shared__ __attribute__((aligned(16))) unsigned char lds_raw[];
    LAS unsigned char* lds = (LAS unsigned char*)lds_raw;
    volatile LAS unsigned* misc = (volatile LAS unsigned*)(lds + LDS_RING);
    cg::grid_group grid = cg::this_grid();
    if (threadIdx.x < 16) misc[threadIdx.x] = 0u;
    __syncthreads();
    (void)xcd_barrier_post((unsigned*)(a.ws + WS_CTL) + 1024, misc + 8);
#define GRID_SYNC() do { XcdBarrier xb_; xb_.bar = (unsigned*)(a.ws + WS_CTL) + 1024; xb_.x = xb_xcc_id(); xb_.st = misc + 8; xcd_barrier(xb_); } while (0)
#define FRESH_IDS() int tid = threadIdx.x; asm volatile("" : "+v"(tid)); const int lane = tid & 63, wid = __builtin_amdgcn_readfirstlane(tid >> 6); const int gw = blockIdx.x * NWAVES + wid; (void)lane; (void)gw
    const int G = gridDim.x, ngw = G * NWAVES;
#ifdef DIAG
#define STAMP(k) do { if (blockIdx.x == 0 && threadIdx.x == 0) misc[8 + (k)] = (unsigned)__builtin_amdgcn_s_memrealtime(); } while (0)
#else
#define STAMP(k) do {} while (0)
#endif
    STAMP(0);
    unsigned char* ws = a.ws;
    unsigned* ctl = (unsigned*)(ws + WS_CTL);
    pg8::f32x2* tabD = (pg8::f32x2*)(ws + WS_TAB);
    pg8::f32x2* tabL = (pg8::f32x2*)(ws + WS_TAB + 512 * 1024);
    bf16_t* XN = (bf16_t*)(ws + WS_XN); bf16_t* PROJ = (bf16_t*)(ws + WS_PROJ); bf16_t* HB = (bf16_t*)(ws + WS_PROJ); bf16_t* MIX = (bf16_t*)(ws + WS_MIX);
    unsigned long long* SSQ = (unsigned long long*)(ws + WS_CTL + 65536);
    float* DIFFO = (float*)(ws + WS_DIFFO); f32x2* ML = (f32x2*)(ws + WS_ML); float* DLSE = (float*)(ws + WS_DLSE);

#ifdef EXTRA_SYNCS
    for (int i = 0; i < EXTRA_SYNCS; ++i) grid.sync();
#endif
#ifdef EXTRA_BARS
    for (int i = 0; i < EXTRA_BARS; ++i) GRID_SYNC();
#endif
#ifndef PRO_REPS
#define PRO_REPS 1
#endif
    for (int rep = 0; rep < PRO_REPS; ++rep) {
        FRESH_IDS();
        LAS float* scr = (LAS float*)(lds + wid * 16384);
        constexpr int I_IN = 32 * 192, I_OUT = 32 * 64, I_GU = 32 * 352, I_DN = 88 * 64, I_L = I_IN + I_OUT + I_GU + I_DN;
#define PRO_DECODE(T, it_) do { T.valid = false; T.gk = nullptr; T.pk = 0; const int it__ = (it_); if (it__ < DEPTH * I_L) { const int L = it__ / I_L; int r = it__ % I_L; \
            if (r < I_IN) { const int kb = r / 192, nb = r % 192, dr0 = 32 * nb; \
                if (dr0 >= 1536 && dr0 < 2560) T.pk = ((dr0 & 63) == 0) ? 1 : 0; else if (dr0 >= 3072 && dr0 < 5120) T.pk = ((dr0 & 127) == 0) ? 2 : 0; \
                T.N = NPROJ; T.K = DM; T.k0 = 64 * kb; T.src = a.w_in + (size_t)L * DM * NPROJ + (size_t)T.k0 * NPROJ + dr0; \
                T.dst = (bf16_t*)(ws + WS_WIN) + (size_t)L * NPROJ * DM + (size_t)dr0 * DM + T.k0; T.gk = a.norm_mix_g + L * DM; T.valid = true; } \
            else { r -= I_IN; \
                if (!(L == 1 && (r < I_OUT + I_GU / 2 || r >= I_OUT + I_GU))) { \
                    if (r < I_OUT) { const int kb = r / 64, nb = r % 64; T.N = DM; T.K = DM; T.k0 = 64 * kb; \
                        T.src = a.w_out + (size_t)L * DM * DM + (size_t)T.k0 * DM + 32 * nb; T.dst = (bf16_t*)(ws + WS_WOUT) + (size_t)L * DM * DM + (size_t)(32 * nb) * DM + T.k0; T.valid = true; } \
                    else if (r < I_OUT + I_GU) { r -= I_OUT; const int kb = r / 352, nb = r % 352, dr0 = 32 * nb, tile = dr0 >> 8, within = dr0 & 255; \
                        T.N = DFF; T.K = DM; T.k0 = 64 * kb; T.src = ((within >> 7) ? a.w_up : a.w_gate) + (size_t)L * DM * DFF + (size_t)T.k0 * DFF + tile * 128 + (within & 127); \
                        T.dst = (bf16_t*)(ws + WS_WGU) + (size_t)L * NGU * DM + (size_t)dr0 * DM + T.k0; T.gk = a.norm_ffn_g + L * DM; T.valid = true; } \
                    else { r -= I_OUT + I_GU; const int kb = r / 64, nb = r % 64; T.N = DM; T.K = DFF; T.k0 = 64 * kb; \
                        T.src = a.w_down + (size_t)L * DFF * DM + (size_t)T.k0 * DM + 32 * nb; T.dst = (bf16_t*)(ws + WS_WDN) + (size_t)L * DM * DFF + (size_t)(32 * nb) * DFF + T.k0; T.valid = true; } } } } } while (0)
        {
            TrDesc dA, dB; float tvA[32], tvB[32];
            int it = gw;
            PRO_DECODE(dA, it); if (dA.valid) tr_load(dA, lane, tvA);
            while (it < DEPTH * I_L) {
                PRO_DECODE(dB, it + ngw); if (dB.valid) tr_load(dB, lane, tvB);
                if (dA.valid) tr_finish(dA, tvA, scr, lane);
                PRO_DECODE(dA, it + 2 * ngw); if (dA.valid) tr_load(dA, lane, tvA);
                if (dB.valid) tr_finish(dB, tvB, scr, lane);
                it += 2 * ngw;
            }
        }
#undef PRO_DECODE
        for (int idx = blockIdx.x * NTHREADS + tid; idx < MROWS * 24; idx += G * NTHREADS) {
            const int row = idx / 24, i = idx % 24;
            const float ang = (float)a.pos[row] * INVF[i];
            float s, c; sincos_acc(ang, s, c);
            if (i < 8) tabD[(size_t)row * 8 + i] = (pg8::f32x2){c, s}; else tabL[(size_t)row * 16 + (i - 8)] = (pg8::f32x2){c, s};
        }
        xb_rows(a.x, XN, SSQ, gw, ngw, lane);
    }
    if (a.ws == nullptr) grid.sync();
    GRID_SYNC(); STAMP(1);

    for (int L = 0; L < DEPTH; ++L) {
        {
            pg8::Gemm g{XN, (const bf16_t*)(ws + WS_WIN) + (size_t)L * NPROJ * DM, MROWS, NPROJ, DM};
            pg8::StaticOrder S; S.init(MROWS, NPROJ, G, (int)blockIdx.x);
            pg8::EpiProj E{PROJ, tabD, tabL, SSQ + (size_t)(2 * L) * MROWS};
#ifndef G1_REPS
#define G1_REPS 1
#endif
#ifndef G1_ALIGN
#define G1_ALIGN true
#endif
            for (int rep = 0; rep < G1_REPS; ++rep) { if (rep) GRID_SYNC(); pg8::gemm_phase<pg8::EpiProj, pg8::StaticOrder, G1_ALIGN, true>(lds, g, S, E); }
#ifdef G1_ALT
            { GRID_SYNC(); pg8::EpiSwiglu E2{(bf16_t*)DIFFO, SSQ + (size_t)(2 * L) * MROWS}; pg8::gemm_phase<pg8::EpiSwiglu, pg8::StaticOrder, true, true>(lds, g, S, E2); }
#endif
        }
        GRID_SYNC(); STAMP(2 + 8 * L + 0);
#ifndef ATT_REPS
#define ATT_REPS 1
#endif
        for (int rep = 0; rep < ATT_REPS; ++rep) {
            if (rep) GRID_SYNC();
            FRESH_IDS();
            unsigned* ctr = ctl + 64 * (1 + L + 2 * rep);
            for (;;) {
                int tid = threadIdx.x; asm volatile("" : "+v"(tid));
                const int lane = tid & 63;
                __syncthreads();
                if (tid == 0) misc[0] = atomicAdd(ctr, 1u);
                __syncthreads();
                const int idx = (int)misc[0];
                if (idx >= Q_TOTAL) break;
                int seg = 0;
#pragma unroll
                for (int sgi = 1; sgi < Q_NSEG; ++sgi) seg += (idx >= QSEG_START[sgi]) ? 1 : 0;
                const int kind = QSEG_KIND[seg], k = idx - QSEG_START[seg]; int qb = QSEG_QB[seg];
#ifdef ATT_REP_KIND
                if (rep > 0 && (kind & 1 ? 1 : kind) != ATT_REP_KIND) continue;
#endif
                if (kind == 0) {
                    qb = 15 - (k >> 3);
                    const int b = (k >> 2) & 1, head = k & 3;
                    f32x16 o[4]; float ls, mm;
                    causal_unit<0>(PROJ, b, qb, head * 128, 512 + head * 128, 1024 + head * 128, lds, tid, wid, lane, 0, 4 * (qb + 1), 0, 1, misc + 16, o, ls, mm);
                    const int qpos = qb * 256 + 32 * wid + (lane & 31);
                    (void)qpos;
                    stage_store_bf16(lds + wid * OST_WAVE, o, head_norm_scale(o), a.g_sb + L * 128, lane, MIX + ((size_t)b * SEQ + qb * 256 + 32 * wid) * DM + head * 128, DM);
                } else if (kind == 1 || kind == 3) {
                    const int split = (kind == 3) ? (k & 1) : 0, kk = (kind == 3) ? (k >> 1) : k;
                    const int comp = kk & 1, head = (kk >> 1) & 3, b = kk >> 3;
                    const int NTt = 4 * (qb + 1);
                    const int t_lo = (kind == 3 && split == 1) ? NTt / 2 : 0, t_hi = (kind == 3 && split == 0) ? NTt / 2 : NTt;
                    f32x16 o[4]; float ls, mm;
                    causal_unit<1>(PROJ, b, qb, 1536 + head * 128 + comp * 64, 2048 + head * 128 + comp * 64, 2560 + head * 128, lds, tid, wid, lane, t_lo, t_hi, 0, 1, misc + 16, o, ls, mm);
                    const int qpos = qb * 256 + 32 * wid + (lane & 31), h = lane >> 5;
                    const size_t row = (size_t)b * SEQ + qpos;
                    stage_store_bf16(lds + wid * OST_WAVE, o, 1.0f / ls, nullptr, lane, (bf16_t*)DIFFO + (size_t)(comp * 2 + split) * MROWS * 512 + ((size_t)b * SEQ + qb * 256 + 32 * wid) * 512 + head * 128, 512);
                    if (h == 0) ML[((size_t)(comp * 2 + split) * MROWS + row) * 4 + head] = (f32x2){mm, ls};
                } else {
                    const int u16 = k & 15, head = (k >> 4) & 7, b = (k >> 7) & 1, pat = k >> 8;
                    const int stride = pat == 0 ? 16 : (pat == 1 ? 4 : 1);
                    const int cls = u16 % stride, blk = u16 / stride;
                    const int t_hi = 4 * (blk + 1), t_lo = (4 * blk - 2) < 0 ? 0 : (4 * blk - 2);
                    f32x16 o[4]; float ls, mm;
                    causal_unit<2>(PROJ, b, blk, 3072 + head * 128, 4096 + head * 128, 5120 + head * 128, lds, tid, wid, lane, t_lo, t_hi, cls, stride, misc + 16, o, ls, mm);
                    const int qidx = blk * 256 + 32 * wid + (lane & 31), h = lane >> 5;
                    const size_t row = (size_t)b * SEQ + cls + (size_t)stride * qidx;
                    const float inv = 1.0f / ls;
                    bf16_t* dst0 = ((pat == 2) ? (bf16_t*)(ws + WS_DILP2) : (bf16_t*)a.out + (size_t)pat * MROWS * 1024) + ((size_t)b * SEQ + cls + (size_t)stride * (blk * 256 + 32 * wid)) * 1024 + head * 128;
                    stage_store_bf16(lds + wid * OST_WAVE, o, inv, nullptr, lane, dst0, (size_t)stride * 1024);
                    if (h == 0) DLSE[((size_t)pat * MROWS + row) * 8 + head] = mm + __builtin_amdgcn_logf(ls);
                }
            }
        }
        GRID_SYNC(); STAMP(2 + 8 * L + 1);
        {
            FRESH_IDS();
            const float lambda_init = (L == 0) ? 0.2f : 0.35550906759096934f;
            const float s1 = wave_sum(a.lq1[L * 64 + lane] * a.lk1[L * 64 + lane]), s2 = wave_sum(a.lq2[L * 64 + lane] * a.lk2[L * 64 + lane]);
            const float lam = expf(s1) - expf(s2) + lambda_init;
            const int grp = lane >> 4, l16 = lane & 15;
            const f32x4 gd0 = *(const f32x4*)(a.g_diff + L * 128 + 8 * l16), gd1 = *(const f32x4*)(a.g_diff + L * 128 + 8 * l16 + 4);
            for (int it = gw * 4 + grp; it < MROWS * 4; it += ngw * 4) {
                const int row = it >> 2, head = it & 3;
                const bool two = ((row & (SEQ - 1)) >= 2048);
                f32x4 on[2][2];
#pragma unroll
                for (int comp = 0; comp < 2; ++comp) {
                    const size_t i0 = (size_t)(comp * 2) * MROWS + row, i1 = i0 + MROWS;
                    const u32x4 w0 = *(const u32x4*)((const bf16_t*)DIFFO + i0 * 512 + head * 128 + 8 * l16);
                    f32x4 oa = (f32x4){__builtin_bit_cast(float, w0.x << 16), __builtin_bit_cast(float, w0.x & 0xffff0000u), __builtin_bit_cast(float, w0.y << 16), __builtin_bit_cast(float, w0.y & 0xffff0000u)};
                    f32x4 ob = (f32x4){__builtin_bit_cast(float, w0.z << 16), __builtin_bit_cast(float, w0.z & 0xffff0000u), __builtin_bit_cast(float, w0.w << 16), __builtin_bit_cast(float, w0.w & 0xffff0000u)};
                    if (two) {
                        const f32x2 ml0 = ML[i0 * 4 + head], ml1 = ML[i1 * 4 + head];
                        const u32x4 w1 = *(const u32x4*)((const bf16_t*)DIFFO + i1 * 512 + head * 128 + 8 * l16);
                        const f32x4 qa = (f32x4){__builtin_bit_cast(float, w1.x << 16), __builtin_bit_cast(float, w1.x & 0xffff0000u), __builtin_bit_cast(float, w1.y << 16), __builtin_bit_cast(float, w1.y & 0xffff0000u)};
                        const f32x4 qb_ = (f32x4){__builtin_bit_cast(float, w1.z << 16), __builtin_bit_cast(float, w1.z & 0xffff0000u), __builtin_bit_cast(float, w1.w << 16), __builtin_bit_cast(float, w1.w & 0xffff0000u)};
                        const float M = fmaxf(ml0.x, ml1.x); float a0 = ml0.y * __builtin_amdgcn_exp2f(ml0.x - M), a1 = ml1.y * __builtin_amdgcn_exp2f(ml1.x - M);
                        const float ia = 1.0f / (a0 + a1); a0 *= ia; a1 *= ia;
                        oa = oa * a0 + qa * a1; ob = ob * a0 + qb_ * a1;
                    }
                    on[comp][0] = oa; on[comp][1] = ob;
                }
                const f32x4 va = on[0][0] - lam * on[1][0], vb = on[0][1] - lam * on[1][1];
                float ss = (va.x * va.x + va.y * va.y) + (va.z * va.z + va.w * va.w) + (vb.x * vb.x + vb.y * vb.y) + (vb.z * vb.z + vb.w * vb.w);
                ss += __shfl_xor(ss, 1); ss += __shfl_xor(ss, 2); ss += __shfl_xor(ss, 4); ss += __shfl_xor(ss, 8);
                const float sc = (1.0f - lambda_init) / sqrtf(ss * (1.0f / 128.0f) + NORM_EPS);
                u32x4 w; w.x = pk2(va.x * sc * gd0.x, va.y * sc * gd0.y); w.y = pk2(va.z * sc * gd0.z, va.w * sc * gd0.w);
                w.z = pk2(vb.x * sc * gd1.x, vb.y * sc * gd1.y); w.w = pk2(vb.z * sc * gd1.z, vb.w * sc * gd1.w);
                *(u32x4*)(MIX + (size_t)row * DM + 512 + head * 128 + 8 * l16) = w;
            }
            const f32x4 gl0 = *(const f32x4*)(a.g_dil + L * 128 + 8 * l16), gl1 = *(const f32x4*)(a.g_dil + L * 128 + 8 * l16 + 4);
            for (int it = gw * 4 + grp; it < MROWS * 8; it += ngw * 4) {
                const int row = it >> 3, head = it & 7;
                float lse[3]; u32x4 pw[3];
#pragma unroll
                for (int p = 0; p < 3; ++p) { lse[p] = DLSE[((size_t)p * MROWS + row) * 8 + head];
                    const bf16_t* src = (p == 2) ? (const bf16_t*)(ws + WS_DILP2) : (const bf16_t*)a.out + (size_t)p * MROWS * 1024;
                    pw[p] = *(const u32x4*)(src + (size_t)row * 1024 + head * 128 + 8 * l16); }
                const float M = fmaxf(fmaxf(lse[0], lse[1]), lse[2]);
                float w0 = __builtin_amdgcn_exp2f(lse[0] - M), w1 = __builtin_amdgcn_exp2f(lse[1] - M), w2 = __builtin_amdgcn_exp2f(lse[2] - M);
                const float iw = 1.0f / (w0 + w1 + w2); w0 *= iw; w1 *= iw; w2 *= iw;
                float v[8]; float ss = 0.f;
#pragma unroll
                for (int e = 0; e < 4; ++e) {
                    const unsigned u0 = pw[0][e], u1 = pw[1][e], u2 = pw[2][e];
                    v[2 * e] = __builtin_bit_cast(float, u0 << 16) * w0 + __builtin_bit_cast(float, u1 << 16) * w1 + __builtin_bit_cast(float, u2 << 16) * w2;
                    v[2 * e + 1] = __builtin_bit_cast(float, u0 & 0xffff0000u) * w0 + __builtin_bit_cast(float, u1 & 0xffff0000u) * w1 + __builtin_bit_cast(float, u2 & 0xffff0000u) * w2;
                    ss += v[2 * e] * v[2 * e] + v[2 * e + 1] * v[2 * e + 1];
                }
                ss += __shfl_xor(ss, 1); ss += __shfl_xor(ss, 2); ss += __shfl_xor(ss, 4); ss += __shfl_xor(ss, 8);
                const float sc = 1.0f / sqrtf(ss * (1.0f / 128.0f) + NORM_EPS);
                u32x4 w; w.x = pk2(v[0] * sc * gl0.x, v[1] * sc * gl0.y); w.y = pk2(v[2] * sc * gl0.z, v[3] * sc * gl0.w);
                w.z = pk2(v[4] * sc * gl1.x, v[5] * sc * gl1.y); w.w = pk2(v[6] * sc * gl1.z, v[7] * sc * gl1.w);
                *(u32x4*)(MIX + (size_t)row * DM + 1024 + head * 128 + 8 * l16) = w;
            }
        }
        GRID_SYNC(); STAMP(2 + 8 * L + 2);
        {
            pg8::Gemm g{MIX, (const bf16_t*)(ws + WS_WOUT) + (size_t)L * DM * DM, MROWS, DM, DM};
            pg8::StaticOrder S; S.init(MROWS, DM, G, (int)blockIdx.x);
            pg8::EpiResidNormB E{XN, SSQ + (size_t)(2 * L + 1) * MROWS};
            pg8::gemm_phase<pg8::EpiResidNormB, pg8::StaticOrder, true, true>(lds, g, S, E);
#ifdef G2_REPS
            { GRID_SYNC(); pg8::EpiResid E2{a.x, DIFFO}; pg8::gemm_phase<pg8::EpiResid, pg8::StaticOrder, true, true>(lds, g, S, E2); }
#endif
        }
        GRID_SYNC(); STAMP(2 + 8 * L + 3);
        {
            pg8::Gemm g{XN, (const bf16_t*)(ws + WS_WGU) + (size_t)L * NGU * DM, MROWS, NGU, DM};
            pg8::StaticOrder S; S.init(MROWS, NGU, G, (int)blockIdx.x);
            pg8::EpiSwiglu E{HB, SSQ + (size_t)(2 * L + 1) * MROWS};
#ifndef G3_REPS
#define G3_REPS 1
#endif
            for (int rep = 0; rep < G3_REPS; ++rep) { if (rep) GRID_SYNC(); pg8::gemm_phase<pg8::EpiSwiglu, pg8::StaticOrder, true, true>(lds, g, S, E); }
            if (DEPTH > 1 && (int)blockIdx.x * 2 >= G) {
                FRESH_IDS();
                LAS float* scr = (LAS float*)(lds + wid * 16384);
                const int hw = ((int)blockIdx.x - G / 2) * NWAVES + wid, nhw = (G - G / 2) * NWAVES;
                constexpr int J_OUT = 32 * 64, J_GUH = 16 * 352, J_DN = 88 * 64;
                if (L == 0) {
                    for (int r = hw; r < J_OUT + J_GUH; r += nhw) {
                        if (r < J_OUT) { const int kb = r / 64, nb = r % 64;
                            tr_item(a.w_out + (size_t)DM * DM, DM, DM, 32 * nb, 0, (bf16_t*)(ws + WS_WOUT) + (size_t)DM * DM, 32 * nb, 64 * kb, scr, lane); }
                        else { const int r2 = r - J_OUT, kb = r2 / 352, nb = r2 % 352, dr0 = 32 * nb, tile = dr0 >> 8, within = dr0 & 255;
                            const float* src = (within >> 7) ? a.w_up : a.w_gate;
                            tr_item(src + (size_t)DM * DFF, DM, DFF, tile * 128 + (within & 127), 0, (bf16_t*)(ws + WS_WGU) + (size_t)NGU * DM, dr0, 64 * kb, scr, lane, a.norm_ffn_g + DM); }
                    }
                } else if (L == 1) {
                    for (int r = hw; r < J_DN; r += nhw) { const int kb = r / 64, nb = r % 64;
                        tr_item(a.w_down + (size_t)DFF * DM, DFF, DM, 32 * nb, 0, (bf16_t*)(ws + WS_WDN) + (size_t)DM * DFF, 32 * nb, 64 * kb, scr, lane); }
                }
            }
        }
        GRID_SYNC(); STAMP(2 + 8 * L + 5);
        {
            pg8::Gemm g{HB, (const bf16_t*)(ws + WS_WDN) + (size_t)L * DM * DFF, MROWS, DM, DFF};
            pg8::StaticOrder S; S.init(MROWS, DM, G, (int)blockIdx.x);
            if (L + 1 < DEPTH) { pg8::EpiResidNormB E{XN, SSQ + (size_t)(2 * L + 2) * MROWS}; pg8::gemm_phase<pg8::EpiResidNormB, pg8::StaticOrder, true, true>(lds, g, S, E); }
            else { pg8::EpiResidB2F E{XN, a.out}; pg8::gemm_phase<pg8::EpiResidB2F, pg8::StaticOrder, true, true>(lds, g, S, E); }
#ifdef G4_REPS
            { GRID_SYNC(); pg8::EpiResid E2{a.out, DIFFO}; pg8::gemm_phase<pg8::EpiResid, pg8::StaticOrder, true, true>(lds, g, S, E2); }
#endif
        }
        GRID_SYNC(); STAMP(2 + 8 * L + 6);
        if (L + 1 == DEPTH) { FRESH_IDS(); rms_rows_f32_inplace(a.out, a.norm_final_g, gw, ngw, lane); }
    }
#ifdef DIAG
    GRID_SYNC(); STAMP(20);
    if (blockIdx.x == 0) {
        __syncthreads();
        const float t1 = (float)(misc[8 + DIAG_T1B] - misc[8 + DIAG_T1A]) * 0.01f;
        const float t2 = (float)(misc[8 + DIAG_T2B] - misc[8 + DIAG_T2A]) * 0.01f;
        for (int i = threadIdx.x; i < (1 << 20); i += NTHREADS) a.out[i] += t2 * 0.25f;
        if (threadIdx.x == 0) a.out[(size_t)8191 * DM] += t1;
    }
#endif
}

extern "C" void kernel_launch(void* const* d_in, const int* in_sizes, int n_in, void* d_out, int out_size, void* d_ws, size_t ws_size, hipStream_t stream) {
    static int grid = 0;
    if (grid == 0) {
        if (n_in != 17 || out_size != MROWS * DM || ws_size < WS_END) { fprintf(stderr, "kernel_launch: unexpected shapes (n_in %d out %d ws %zu)\n", n_in, out_size, ws_size); grid = -1; return; }
        int dev = 0, cus = 0, per_cu = 0;
        hipGetDevice(&dev); hipDeviceGetAttribute(&cus, hipDeviceAttributeMultiprocessorCount, dev);
        if (hipFuncSetAttribute((const void*)mega_fwd, hipFuncAttributeMaxDynamicSharedMemorySize, LDS_BYTES) != hipSuccess) { fprintf(stderr, "kernel_launch: hipFuncSetAttribute failed\n"); }
        hipOccupancyMaxActiveBlocksPerMultiprocessor(&per_cu, (const void*)mega_fwd, NTHREADS, LDS_BYTES);
        (void)hipGetLastError();
        if (per_cu < 1) { fprintf(stderr, "kernel_launch: occupancy query says %d blocks per CU\n", per_cu); per_cu = 1; }
        grid = cus;
    }
    if (grid < 0) return;
    hipMemsetAsync((char*)d_ws + WS_CTL, 0, 65536 + 4 * MROWS * 8, stream);
    Args a{};
    a.x = (const float*)d_in[0]; a.pos = (const int*)d_in[1]; a.norm_mix_g = (const float*)d_in[2]; a.w_in = (const float*)d_in[3];
    a.lq1 = (const float*)d_in[4]; a.lk1 = (const float*)d_in[5]; a.lq2 = (const float*)d_in[6]; a.lk2 = (const float*)d_in[7];
    a.g_sb = (const float*)d_in[8]; a.g_diff = (const float*)d_in[9]; a.g_dil = (const float*)d_in[10]; a.w_out = (const float*)d_in[11];
    a.norm_ffn_g = (const float*)d_in[12]; a.w_gate = (const float*)d_in[13]; a.w_up = (const float*)d_in[14]; a.w_down = (const float*)d_in[15];
    a.norm_final_g = (const float*)d_in[16]; a.out = (float*)d_out; a.ws = (unsigned char*)d_ws;
    void* args[] = {&a};
    hipError_t e = hipLaunchCooperativeKernel((const void*)mega_fwd, dim3(grid), dim3(NTHREADS), args, LDS_BYTES, stream);
    if (e != hipSuccess) fprintf(stderr, "kernel_launch: cooperative launch failed: %s (grid %d)\n", hipGetErrorString(e), grid);
}
```
